# Optimizing an MI355X kernel written in HIP

```python
import math
import jax, jax.numpy as jnp
from jax import lax
import numpy as np

D_MODEL = 1024
BATCH = 8
SEQ = 4096
DEPTH = 2
DEC_BATCH = 16
DEC_SEQ = 32
PAST_LEN = 4096

CHUNK = 64
POOL_WIDTH = D_MODEL // 4
POOL_WINDOWS = (2, 4, 8, 16)
POOL_GROUPS = len(POOL_WINDOWS)
POOL_GROUP_DIM = POOL_WIDTH // POOL_GROUPS
POOL_STATE = max(POOL_WINDOWS) - 1
CONV_DIM = D_MODEL // 4
CONV_K = 3
QK_DIM = 64
V_DIM = 2 * QK_DIM
ATTN_WIDTH = D_MODEL // 2
ATTN_HEADS = ATTN_WIDTH // V_DIM
QK_COLS = ATTN_HEADS * 2 * QK_DIM
MIX_WIDTH = POOL_WIDTH + CONV_DIM + ATTN_WIDTH
SPLIT_SIZES = (POOL_WIDTH, CONV_DIM, CONV_DIM, CONV_DIM, QK_COLS, QK_COLS, ATTN_WIDTH)
IN_COLS = sum(SPLIT_SIZES)
Q_BLOCK = 128
NUM_BUCKETS = 32
MAX_DISTANCE = 128
D_FF = 2816
ALPHA = (2 * DEPTH) ** 0.25
BETA = (8 * DEPTH) ** -0.25
LN_EPS = 1e-5
RMS_EPS = 1e-5
NEG_INF = -1e30

kernel_name = "hybrid_pool_conv_diffattn_streaming_encoder_step"


def layer_norm(x, g, b):
    xf = x.astype(jnp.float32)
    mu = jnp.mean(xf, axis=-1, keepdims=True)
    var = jnp.mean(jnp.square(xf - mu), axis=-1, keepdims=True)
    return ((xf - mu) * lax.rsqrt(var + LN_EPS) * g.astype(jnp.float32) + b.astype(jnp.float32)).astype(x.dtype)


def swiglu(x, w_in, w_out):
    gate, up = jnp.split(x @ w_in, 2, axis=-1)
    return (jax.nn.silu(gate) * up) @ w_out


def pool_mixer(u, left, pos, pool_w, pool_scale):
    b, s = u.shape[:2]
    ext = jnp.concatenate([left.astype(u.dtype), u], axis=1)
    cs = jnp.cumsum(ext.astype(jnp.float32), axis=1)
    cs = jnp.pad(cs, ((0, 0), (1, 0), (0, 0)))
    end = POOL_STATE + 1
    means = []
    for g, w in enumerate(POOL_WINDOWS):
        sl = slice(g * POOL_GROUP_DIM, (g + 1) * POOL_GROUP_DIM)
        win_sum = cs[:, end:end + s, sl] - cs[:, end - w:end - w + s, sl]
        count = jnp.minimum(w, pos + 1).astype(jnp.float32)[None, :, None]
        means.append(win_sum / count)
    mean = jnp.concatenate(means, axis=-1)
    d = (mean - u.astype(jnp.float32)).astype(u.dtype).reshape(b, s, POOL_GROUPS, POOL_GROUP_DIM)
    y = jnp.einsum("bsgc,gcd->bsgd", d, pool_w).reshape(b, s, POOL_WIDTH) * pool_scale
    return y, ext[:, -POOL_STATE:]


def short_conv(b_gate, c_gate, h, left, conv_w):
    z = c_gate * h
    s = z.shape[1]
    ext = jnp.concatenate([left.astype(z.dtype), z], axis=1)
    y = sum(conv_w[j] * ext[:, j:j + s] for j in range(CONV_K))
    return b_gate * y, ext[:, -(CONV_K - 1):]


def t5_bucket(rel):
    nb = NUM_BUCKETS // 2
    max_exact = nb // 2
    ret = (rel > 0).astype(jnp.int32) * nb
    n = jnp.abs(rel)
    nf = jnp.maximum(n, 1).astype(jnp.float32)
    large = max_exact + (jnp.log(nf / max_exact) / math.log(MAX_DISTANCE / max_exact) * (nb - max_exact)).astype(jnp.int32)
    large = jnp.minimum(large, nb - 1)
    return ret + jnp.where(n < max_exact, n, large)


def diff_attn_block(q, k, v, q_pos, k_pos, rel_bias, lam):
    bias = jnp.transpose(rel_bias[t5_bucket(k_pos[None, :] - q_pos[:, None])], (2, 0, 1)).astype(jnp.float32)
    mask = (k_pos[None, :] // CHUNK) <= (q_pos[:, None] // CHUNK)
    s = jnp.einsum("bqhcd,bkhcd->bchqk", q.astype(jnp.float32), k.astype(jnp.float32)) * (QK_DIM ** -0.5) + bias
    s = jnp.where(mask, s, NEG_INF)
    p = jax.nn.softmax(s, axis=-1)
    w = p[:, 0] - lam * p[:, 1]
    return jnp.einsum("bhqk,bkhd->bqhd", w, v.astype(jnp.float32))


def diff_attention(q, k, v, q_pos, k_pos, rel_bias, lam, lam_init, subln_g, sweep):
    b, s = q.shape[:2]
    if sweep:
        nblk = s // Q_BLOCK
        qb = jnp.moveaxis(q.reshape(b, nblk, Q_BLOCK, ATTN_HEADS, 2, QK_DIM), 1, 0)
        pb = q_pos.reshape(nblk, Q_BLOCK)
        o = lax.map(lambda a: diff_attn_block(a[0], k, v, a[1], k_pos, rel_bias, lam), (qb, pb))
        o = jnp.moveaxis(o, 0, 1).reshape(b, s, ATTN_HEADS, V_DIM)
    else:
        o = diff_attn_block(q, k, v, q_pos, k_pos, rel_bias, lam)
    o = o * lax.rsqrt(jnp.mean(jnp.square(o), axis=-1, keepdims=True) + RMS_EPS) * subln_g.astype(jnp.float32)
    o = o * (1.0 - lam_init)
    return o.reshape(b, s, ATTN_WIDTH).astype(q.dtype)


def encoder_layer(x, pos, pool_left, conv_left, past_k, past_v, lam_init,
                  ln_g, ln_b, w_ffn_in, w_ffn_out, w_in, w_out,
                  pool_w, pool_scale, conv_w, diff_lambda, subln_g, rel_bias):
    b, s = x.shape[:2]
    x = layer_norm(ALPHA * x + 0.5 * swiglu(x, w_ffn_in[0], w_ffn_out[0]), ln_g[0], ln_b[0])
    proj = x @ w_in
    parts = []
    off = 0
    for n in SPLIT_SIZES:
        parts.append(proj[..., off:off + n])
        off += n
    u_pool, b_gate, c_gate, h_conv, q, k, v = parts
    q = q.reshape(b, s, ATTN_HEADS, 2, QK_DIM)
    k = k.reshape(b, s, ATTN_HEADS, 2, QK_DIM)
    v = v.reshape(b, s, ATTN_HEADS, V_DIM)
    if past_k is None:
        kk, vv, k_pos, sweep = k, v, pos, True
    else:
        p_len = past_k.shape[1]
        kk = jnp.concatenate([past_k.reshape(b, p_len, ATTN_HEADS, 2, QK_DIM).astype(k.dtype), k], axis=1)
        vv = jnp.concatenate([past_v.astype(v.dtype), v], axis=1)
        k_pos = jnp.concatenate([jnp.arange(p_len, dtype=jnp.int32), pos])
        sweep = False
    dl = diff_lambda.astype(jnp.float32)
    lam = jnp.exp(jnp.sum(dl[0] * dl[1])) - jnp.exp(jnp.sum(dl[2] * dl[3])) + lam_init
    attn = diff_attention(q, kk, vv, pos, k_pos, rel_bias, lam, lam_init, subln_g, sweep)
    pool_out, pool_state = pool_mixer(u_pool, pool_left, pos, pool_w, pool_scale)
    conv_out, conv_state = short_conv(b_gate, c_gate, h_conv, conv_left, conv_w)
    mix = jnp.concatenate([pool_out, conv_out, attn], axis=-1) @ w_out
    x = layer_norm(ALPHA * x + mix, ln_g[1], ln_b[1])
    x = layer_norm(ALPHA * x + 0.5 * swiglu(x, w_ffn_in[1], w_ffn_out[1]), ln_g[2], ln_b[2])
    return x, k.reshape(b, s, ATTN_HEADS, 2 * QK_DIM), v, pool_state, conv_state


def setup_inputs(seed: int = 0) -> dict:
    key = jax.random.key(seed)
    ks = jax.random.split(key, 20)
    nrm = jax.random.normal
    f32 = jnp.float32
    return {
        "x_prompt": nrm(ks[0], (BATCH, SEQ, D_MODEL), f32),
        "x_sample": nrm(ks[1], (DEC_BATCH, DEC_SEQ, D_MODEL), f32),
        "cache_k": nrm(ks[2], (DEPTH, DEC_BATCH, PAST_LEN, ATTN_HEADS, 2 * QK_DIM), f32),
        "cache_v": nrm(ks[3], (DEPTH, DEC_BATCH, PAST_LEN, ATTN_HEADS, V_DIM), f32),
        "state_pool": nrm(ks[4], (DEPTH, DEC_BATCH, POOL_STATE, POOL_WIDTH), f32),
        "state_conv": nrm(ks[5], (DEPTH, DEC_BATCH, CONV_K - 1, CONV_DIM), f32),
        "ln_g": 1.0 + 0.05 * nrm(ks[6], (DEPTH, 3, D_MODEL), f32),
        "ln_b": 0.02 * nrm(ks[7], (DEPTH, 3, D_MODEL), f32),
        "w_ffn_in": nrm(ks[8], (DEPTH, 2, D_MODEL, 2 * D_FF), f32) * D_MODEL ** -0.5,
        "w_ffn_out": nrm(ks[9], (DEPTH, 2, D_FF, D_MODEL), f32) * (D_FF ** -0.5 * BETA),
        "w_in": nrm(ks[10], (DEPTH, D_MODEL, IN_COLS), f32) * D_MODEL ** -0.5,
        "w_out": nrm(ks[11], (DEPTH, MIX_WIDTH, D_MODEL), f32) * (MIX_WIDTH ** -0.5 * BETA),
        "pool_w": nrm(ks[12], (DEPTH, POOL_GROUPS, POOL_GROUP_DIM, POOL_GROUP_DIM), f32) * POOL_GROUP_DIM ** -0.5,
        "pool_scale": 1.0 + 0.1 * nrm(ks[13], (DEPTH, POOL_WIDTH), f32),
        "conv_w": nrm(ks[14], (DEPTH, CONV_K, CONV_DIM), f32) * CONV_K ** -0.5,
        "diff_lambda": 0.1 * nrm(ks[15], (DEPTH, 4, QK_DIM), f32),
        "subln_g": 1.0 + 0.05 * nrm(ks[16], (DEPTH, V_DIM), f32),
        "rel_bias": 0.5 * nrm(ks[17], (NUM_BUCKETS, ATTN_HEADS), f32),
    }


def reference(x_prompt, x_sample, cache_k, cache_v, state_pool, state_conv,
              ln_g, ln_b, w_ffn_in, w_ffn_out, w_in, w_out,
              pool_w, pool_scale, conv_w, diff_lambda, subln_g, rel_bias):
    bp, sp = x_prompt.shape[:2]
    bs, ss = x_sample.shape[:2]
    past = cache_k.shape[2]
    pos_p = jnp.arange(sp, dtype=jnp.int32)
    pos_s = past + jnp.arange(ss, dtype=jnp.int32)
    hp, hs = x_prompt, x_sample
    kp_l, vp_l, plp_l, cvp_l = [], [], [], []
    ks_l, vs_l, pls_l, cvs_l = [], [], [], []
    for l in range(DEPTH):
        lam_init = 0.8 - 0.6 * math.exp(-0.3 * l)
        lw = (ln_g[l], ln_b[l], w_ffn_in[l], w_ffn_out[l], w_in[l], w_out[l],
              pool_w[l], pool_scale[l], conv_w[l], diff_lambda[l], subln_g[l], rel_bias)
        hp, kp, vp, plp, cvp = encoder_layer(
            hp, pos_p, jnp.zeros((bp, POOL_STATE, POOL_WIDTH), hp.dtype),
            jnp.zeros((bp, CONV_K - 1, CONV_DIM), hp.dtype), None, None, lam_init, *lw)
        hs, k_s, v_s, pls, cvs = encoder_layer(
            hs, pos_s, state_pool[l], state_conv[l], cache_k[l], cache_v[l], lam_init, *lw)
        kp_l.append(kp); vp_l.append(vp); plp_l.append(plp); cvp_l.append(cvp)
        ks_l.append(k_s); vs_l.append(v_s); pls_l.append(pls); cvs_l.append(cvs)
    new_k_prompt = jnp.stack(kp_l)
    new_v_prompt = jnp.stack(vp_l)
    new_pool_prompt = jnp.stack(plp_l)
    new_conv_prompt = jnp.stack(cvp_l)
    new_k_sample = jnp.stack(ks_l)
    new_v_sample = jnp.stack(vs_l)
    new_pool_sample = jnp.stack(pls_l)
    new_conv_sample = jnp.stack(cvs_l)
    return (hp, hs, new_k_prompt, new_v_prompt, new_pool_prompt, new_conv_prompt,
            new_k_sample, new_v_sample, new_pool_sample, new_conv_sample)
```

```cpp
#include <hip/hip_runtime.h>
#include <hip/hip_cooperative_groups.h>
#include <hip/hip_bf16.h>
#include <cstdio>
#include <cstdint>
namespace cg = cooperative_groups;
__device__ __forceinline__ int tid_opaque() { int t = threadIdx.x; asm volatile("" : "+v"(t)); return t; }
namespace pg8 {
#define PG8_LAS __attribute__((address_space(3)))
typedef unsigned short bf16_t;
typedef short bf16x8 __attribute__((ext_vector_type(8)));
typedef float f32x4 __attribute__((ext_vector_type(4)));
typedef unsigned u32x4 __attribute__((ext_vector_type(4)));
constexpr int BM = 256, BK = 64, HALF = 128, HTB = HALF * BK * 2  , STAGE_BYTES = 8 * HTB, NXCD = 8, WGM = 8;

__host__ __device__ __forceinline__ int lds_byte(int r, int c) { const int st = (r >> 4) * 2 + (c >> 5), rr = r & 15, cc = c & 31, ob = rr * 64 + cc * 2; return st * 1024 + (ob ^ (((ob >> 9) & 1) << 5)); }
__host__ __device__ __forceinline__ void stage_rc(int b, int& R, int& C) { const int st = b / 1024, sb = b % 1024, swz = sb ^ (((sb >> 9) & 1) << 5); R = (st >> 1) * 16 + swz / 64; C = (st & 1) * 32 + (swz % 64) / 2; }
__host__ __device__ __forceinline__ int perm32(int rho) { const int n = rho >> 4, i = rho & 15; return 8 * (i >> 2) + 4 * n + (i & 3); }

struct Unit { int pm, pn; };
struct Gemm { const bf16_t* A; const bf16_t* Bt; int M, N, K; };

struct StaticOrder {
    int nM, nN, nwg, G, c;
    __host__ __device__ void init(int M, int N, int G_, int c_) { nM = M / BM; nN = N / BM; nwg = nM * nN; G = G_; c = c_; }
    __host__ __device__ bool next(int i, Unit& u) const {
        const long L = (long)i * G + c; if (L >= nwg) return false;
        int wgid = (int)L; { const int q = nwg / NXCD, r = nwg % NXCD, xcd = wgid % NXCD, off = wgid / NXCD; wgid = (xcd < r ? xcd * (q + 1) : r * (q + 1) + (xcd - r) * q) + off; }
        const int nig = WGM * nN, gid = wgid / nig, fm = gid * WGM, gsz = (nM - fm) < WGM ? (nM - fm) : WGM;
        u.pm = fm + ((wgid % nig) % gsz); u.pn = (wgid % nig) / gsz; return true;
    }
    __device__ __forceinline__ void a_ready(const Unit&) const {}
    __device__ __forceinline__ void done(const Unit&) const {}
};

typedef __bf16 bf16x2_t __attribute__((ext_vector_type(2)));
typedef float f32x2_t __attribute__((ext_vector_type(2)));
__device__ __forceinline__ unsigned pk_bf16(float lo, float hi) { f32x2_t v = {lo, hi}; bf16x2_t b = __builtin_convertvector(v, bf16x2_t); return __builtin_bit_cast(unsigned, b); }
__device__ __forceinline__ float silu_f(float g) { return g * __builtin_amdgcn_rcpf(1.0f + __builtin_amdgcn_exp2f(-1.4426950408889634f * g)); }
constexpr int LD_H = 2816, LD_P = 2816, LD_X = 1024;
constexpr float LNE = 1e-5f;
__device__ __forceinline__ void row_mean_rstd(const float* sp, int row, float& mean, float& rstd) {
    const f32x4 a = *(const f32x4*)(sp + (size_t)row * 8), b = *(const f32x4*)(sp + (size_t)row * 8 + 4);
    const float s1 = (a[0] + a[2]) + (b[0] + b[2]), s2 = (a[1] + a[3]) + (b[1] + b[3]);
    mean = s1 * (1.0f / 1024.0f); const float var = s2 * (1.0f / 1024.0f) - mean * mean; rstd = 1.0f / __builtin_sqrtf(var + LNE);
}
struct FoldOrder : StaticOrder {
    const float* sp; const float* cg; const float* bw; __attribute__((address_space(3))) float* tabs; mutable int ncall;
    __device__ __forceinline__ void a_ready(const Unit& u) const {
        if (ncall != 0 || sp == nullptr) { ++ncall; return; }
        ++ncall;
        const int t = tid_opaque();
        if (t < 256) { float mu, rs; row_mean_rstd(sp, u.pm * BM + t, mu, rs); tabs[2 * t] = mu; tabs[2 * t + 1] = rs; }
        else { const int j = t - 256; tabs[512 + j] = cg[u.pn * BM + j]; tabs[768 + j] = bw[u.pn * BM + j]; }
    }
    __device__ __forceinline__ bool fold_prefetch(int i, f32x4& ra, f32x4& rb) const {
        Unit nx; if (sp == nullptr || !next(i, nx)) return false;
        const int t = tid_opaque();
        if (t < 256) { const float* q = sp + (size_t)(nx.pm * BM + t) * 8; ra = *(const f32x4*)q; rb = *(const f32x4*)(q + 4); }
        else { const int j = t - 256; ra[0] = cg[nx.pn * BM + j]; ra[1] = bw[nx.pn * BM + j]; }
        return true;
    }
    __device__ __forceinline__ void fold_commit(int i, const f32x4& a, const f32x4& b) const {
        __attribute__((address_space(3))) float* T = tabs + (i & 1) * 1024; const int t = tid_opaque();
        if (t < 256) { const float s1 = (a[0] + a[2]) + (b[0] + b[2]), s2 = (a[1] + a[3]) + (b[1] + b[3]);
            const float mean = s1 * (1.0f / 1024.0f), var = s2 * (1.0f / 1024.0f) - mean * mean; T[2 * t] = mean; T[2 * t + 1] = 1.0f / __builtin_sqrtf(var + LNE); }
        else { const int j = t - 256; T[512 + j] = a[0]; T[768 + j] = a[1]; }
    }
};
typedef __attribute__((address_space(3))) const float* ldsf_t;
struct EpiGlu {
    static constexpr bool PERM = true, AFTER_DRAIN = false;
    bf16_t* H; int ln; ldsf_t tabs; const FoldOrder* so; mutable int nepi;
    __device__ __forceinline__ void operator()(const f32x4 (&acc)[2][2][4][2], const Unit& u, int wr, int wc, int fr, int fq) const {
        const int row0 = u.pm * BM + wr * 64 + fr, col0 = u.pn * 128 + wc * 32 + 8 * fq, jc = wc * 32 + 8 * fq;
        ldsf_t T = tabs + (nepi & 1) * 1024;
        f32x4 ra = {0.f, 0.f, 0.f, 0.f}, rb = {0.f, 0.f, 0.f, 0.f}; const bool hn = so->fold_prefetch(nepi + 1, ra, rb);
        f32x4 cgv[4], bwv[4];
        if (ln) {
#pragma unroll
            for (int q = 0; q < 4; ++q) { const int j = jc + (q >> 1) * HALF + (q & 1) * 4; cgv[q] = *(const __attribute__((address_space(3))) f32x4*)(T + 512 + j); bwv[q] = *(const __attribute__((address_space(3))) f32x4*)(T + 768 + j); } }
#pragma unroll
        for (int ai = 0; ai < 2; ++ai)
#pragma unroll
            for (int m = 0; m < 4; ++m) {
                const int rl = wr * 64 + fr + ai * HALF + m * 16;
                bf16_t* rowp = H + (size_t)(u.pm * BM + rl) * LD_H + col0;
                f32x4 g0 = acc[ai][0][m][0], g1 = acc[ai][0][m][1], u0 = acc[ai][1][m][0], u1 = acc[ai][1][m][1];
                if (ln) { const f32x2_t mr = *(const __attribute__((address_space(3))) f32x2_t*)(T + 2 * rl); const float mu = mr[0], rs = mr[1];
                    g0 = (g0 - mu * cgv[0]) * rs + bwv[0]; g1 = (g1 - mu * cgv[1]) * rs + bwv[1]; u0 = (u0 - mu * cgv[2]) * rs + bwv[2]; u1 = (u1 - mu * cgv[3]) * rs + bwv[3]; }
                u32x4 w;
                w.x = pk_bf16(silu_f(g0[0]) * u0[0], silu_f(g0[1]) * u0[1]); w.y = pk_bf16(silu_f(g0[2]) * u0[2], silu_f(g0[3]) * u0[3]);
                w.z = pk_bf16(silu_f(g1[0]) * u1[0], silu_f(g1[1]) * u1[1]); w.w = pk_bf16(silu_f(g1[2]) * u1[2], silu_f(g1[3]) * u1[3]);
                *(u32x4*)rowp = w;
            }
        (void)row0;
        if (hn) so->fold_commit(nepi + 1, ra, rb);
        ++nepi;
    }
};
struct EpiRes {
    static constexpr bool PERM = true, AFTER_DRAIN = false;
    const float* Xin; float* X; float alpha, s;
    int ln; ldsf_t ftab; const FoldOrder* so;
    float* spo; const float* gn; bf16_t* XB;
    __attribute__((address_space(3))) float* tab;
    mutable int nepi;
    __device__ __forceinline__ void operator()(const f32x4 (&acc)[2][2][4][2], const Unit& u, int wr, int wc, int fr, int fq) const {
        const int rl0 = wr * 64 + fr, col0 = u.pn * BM + wc * 32 + 8 * fq, jc = wc * 32 + 8 * fq;
        ldsf_t T = ftab + (nepi & 1) * 1024;
        f32x4 ra = {0.f, 0.f, 0.f, 0.f}, rb = {0.f, 0.f, 0.f, 0.f}; const bool hn = so->fold_prefetch(nepi + 1, ra, rb);
        f32x4 gnv[2][2];
#pragma unroll
        for (int bj = 0; bj < 2; ++bj)
#pragma unroll
            for (int n = 0; n < 2; ++n) gnv[bj][n] = *(const f32x4*)(gn + col0 + bj * HALF + n * 4);
#pragma unroll
        for (int aih = 0; aih < 4; ++aih) { const int ai = aih >> 1, mh = (aih & 1) * 2;
            f32x4 xa[4][2][2];
#pragma unroll
            for (int m = mh; m < mh + 2; ++m) { const size_t ro_ = (size_t)(u.pm * BM + rl0 + ai * HALF + m * 16) * LD_X + col0;
                if (ln) {
#pragma unroll
                    for (int bj = 0; bj < 2; ++bj) { const u32x4 w = *(const u32x4*)(XB + ro_ + bj * HALF);
                        xa[m][bj][0] = (f32x4){__builtin_bit_cast(float, w.x << 16), __builtin_bit_cast(float, w.x & 0xffff0000u), __builtin_bit_cast(float, w.y << 16), __builtin_bit_cast(float, w.y & 0xffff0000u)};
                        xa[m][bj][1] = (f32x4){__builtin_bit_cast(float, w.z << 16), __builtin_bit_cast(float, w.z & 0xffff0000u), __builtin_bit_cast(float, w.w << 16), __builtin_bit_cast(float, w.w & 0xffff0000u)}; }
                } else {
#pragma unroll
                    for (int bj = 0; bj < 2; ++bj)
#pragma unroll
                        for (int n = 0; n < 2; ++n) xa[m][bj][n] = *(const f32x4*)(Xin + ro_ + bj * HALF + n * 4); } }
#pragma unroll
            for (int m = mh; m < mh + 2; ++m) {
                const int rl = rl0 + ai * HALF + m * 16, row = u.pm * BM + rl;
                const size_t ro_ = (size_t)row * LD_X + col0; bf16_t* bp_ = XB + ro_;
                f32x4 xv[2][2];
#pragma unroll
                for (int bj = 0; bj < 2; ++bj)
#pragma unroll
                    for (int n = 0; n < 2; ++n) xv[bj][n] = xa[m][bj][n];
                if (ln) { const f32x2_t mr = *(const __attribute__((address_space(3))) f32x2_t*)(T + 2 * rl); const float mu = mr[0], rs = mr[1];
#pragma unroll
                    for (int bj = 0; bj < 2; ++bj)
#pragma unroll
                        for (int n = 0; n < 2; ++n) { const int j = jc + bj * HALF + n * 4;
                            const f32x4 gg = *(const __attribute__((address_space(3))) f32x4*)(T + 512 + j), bb = *(const __attribute__((address_space(3))) f32x4*)(T + 768 + j);
                            xv[bj][n] = (xv[bj][n] - mu * gg) * rs + bb; } }
                float s1 = 0.f, s2 = 0.f;
#pragma unroll
                for (int bj = 0; bj < 2; ++bj) {
                    const f32x4 y0 = xv[bj][0] * alpha + acc[ai][bj][m][0] * s, y1 = xv[bj][1] * alpha + acc[ai][bj][m][1] * s;
                    if (X) { float* rp = X + ro_; *(f32x4*)(rp + bj * HALF) = y0; *(f32x4*)(rp + bj * HALF + 4) = y1; }
                    const f32x4 g0 = y0 * gnv[bj][0], g1 = y1 * gnv[bj][1];
                    u32x4 w; w.x = pk_bf16(g0[0], g0[1]); w.y = pk_bf16(g0[2], g0[3]); w.z = pk_bf16(g1[0], g1[1]); w.w = pk_bf16(g1[2], g1[3]);
                    *(u32x4*)(bp_ + bj * HALF) = w;
                    s1 += ((y0[0] + y0[1]) + (y0[2] + y0[3])) + ((y1[0] + y1[1]) + (y1[2] + y1[3]));
                    s2 += ((y0[0] * y0[0] + y0[1] * y0[1]) + (y0[2] * y0[2] + y0[3] * y0[3])) + ((y1[0] * y1[0] + y1[1] * y1[1]) + (y1[2] * y1[2] + y1[3] * y1[3])); }
                s1 += __shfl_xor(s1, 16); s1 += __shfl_xor(s1, 32); s2 += __shfl_xor(s2, 16); s2 += __shfl_xor(s2, 32);
                if (fq == 0) { tab[(rl * 4 + wc) * 2] = s1; tab[(rl * 4 + wc) * 2 + 1] = s2; }
            }
        }
        if (hn) so->fold_commit(nepi + 1, ra, rb);
        ++nepi;
        asm volatile("s_waitcnt lgkmcnt(0)" ::: "memory"); __builtin_amdgcn_s_barrier(); asm volatile("" ::: "memory");
        const int t = tid_opaque();
        if (t < 256) { const __attribute__((address_space(3))) float* q = tab + t * 8;
            const float a = (q[0] + q[2]) + (q[4] + q[6]), b = (q[1] + q[3]) + (q[5] + q[7]);
            f32x2_t o = {a, b}; *(f32x2_t*)(spo + ((size_t)(u.pm * BM + t) * 4 + u.pn) * 2) = o; }
    }
};
struct EpiProj {
    static constexpr bool PERM = true, AFTER_DRAIN = false;
    bf16_t* P; float qscale; float* out; int l; int smp_;
    ldsf_t tabs; const FoldOrder* so; mutable int nepi;
    __device__ __forceinline__ void operator()(const f32x4 (&acc)[2][2][4][2], const Unit& u, int wr, int wc, int fr, int fq) const {
        const int pn = u.pn, col0 = pn * BM + wc * 32 + 8 * fq, jc = wc * 32 + 8 * fq;
        ldsf_t T = tabs + (nepi & 1) * 1024;
        f32x4 ra = {0.f, 0.f, 0.f, 0.f}, rb = {0.f, 0.f, 0.f, 0.f}; const bool hn = so->fold_prefetch(nepi + 1, ra, rb);
        const float sc = (pn == 5 || pn == 6) ? qscale : 1.0f;
        const bool has_side = pn >= 7, isk = pn < 9, smp = smp_ != 0;
        const size_t sbase = smp ? ((isk ? (size_t)101257216 : (size_t)101781504) + (size_t)l * 512 * 512) : ((isk ? (size_t)34078720 : (size_t)67633152) + (size_t)l * 32768 * 512);
        const int scol = (pn - (isk ? 7 : 9)) * BM + wc * 32 + 8 * fq;
        f32x4 cgv[4], bwv[4];
#pragma unroll
        for (int q = 0; q < 4; ++q) { const int j = jc + (q >> 1) * HALF + (q & 1) * 4; cgv[q] = *(const __attribute__((address_space(3))) f32x4*)(T + 512 + j); bwv[q] = *(const __attribute__((address_space(3))) f32x4*)(T + 768 + j); }
#pragma unroll
        for (int ai = 0; ai < 2; ++ai)
#pragma unroll
            for (int m = 0; m < 4; ++m) {
                const int rl = wr * 64 + fr + ai * HALF + m * 16, row = u.pm * BM + rl;
                bf16_t* rowp = P + (size_t)row * LD_P + col0;
                const f32x2_t mr = *(const __attribute__((address_space(3))) f32x2_t*)(T + 2 * rl); const float mu = mr[0], rs = mr[1];
#pragma unroll
                for (int bj = 0; bj < 2; ++bj) {
                    const f32x4 v0 = ((acc[ai][bj][m][0] - mu * cgv[2 * bj]) * rs + bwv[2 * bj]) * sc, v1 = ((acc[ai][bj][m][1] - mu * cgv[2 * bj + 1]) * rs + bwv[2 * bj + 1]) * sc;
                    u32x4 w; w.x = pk_bf16(v0[0], v0[1]); w.y = pk_bf16(v0[2], v0[3]); w.z = pk_bf16(v1[0], v1[1]); w.w = pk_bf16(v1[2], v1[3]);
                    *(u32x4*)(rowp + bj * HALF) = w;
                    if (has_side) { float* sp2 = out + sbase + (size_t)row * 512 + scol + bj * HALF; *(f32x4*)sp2 = v0; *(f32x4*)(sp2 + 4) = v1; }
                }
            }
        if (hn) so->fold_commit(nepi + 1, ra, rb);
        ++nepi;
    }
};
template <class Epi, class Sched, bool ALIGN_EPI = false, bool SP2 = false>
__device__ __forceinline__ void gemm_phase(PG8_LAS unsigned char* lds, const Gemm g, const Sched& S, const Epi& E) {
    const int tid = tid_opaque(), wid = __builtin_amdgcn_readfirstlane(tid >> 6), lane = tid & 63, wr = wid >> 2, wc = wid & 3, fr = lane & 15, fq = lane >> 4;
    const int K = g.K, nt = K / BK;
    unsigned voffA[2], voffB[2];
#pragma unroll
    for (int i = 0; i < 2; ++i) { int R, C; stage_rc(tid * 16 + i * 8192, R, C); const int Rb = Epi::PERM ? ((R & ~31) + perm32(R & 31)) : R;
        voffA[i] = (unsigned)(R * K + C) * 2u; voffB[i] = (unsigned)(Rb * K + C) * 2u; }
    const size_t kstep = (size_t)(BK * 2);
    const size_t hstep = (size_t)HALF * K * 2;
    const size_t tstep = 2 * hstep;
    const unsigned ldsw = (unsigned)wid * 1024u;
    const int aoff = lds_byte(wr * 64 + fr, fq * 8), boff = lds_byte(wc * 32 + fr, fq * 8);
#define PG8_SA(b, h) (((b) * 2 + (h)) * HTB)
#define PG8_SB(b, h) ((4 + (b) * 2 + (h)) * HTB)
#define PG8_STAGE(bufoff, gbase, voff) do { _Pragma("unroll") for (int _i = 0; _i < 2; ++_i) \
        __builtin_amdgcn_global_load_lds((const unsigned*)((const char*)(gbase) + (voff)[_i]), (PG8_LAS unsigned*)(lds + (bufoff) + ldsw + _i * 8192), 16, 0, 0); } while (0)
#define PG8_LDA(dst, b, h) do { _Pragma("unroll") for (int m = 0; m < 4; ++m) _Pragma("unroll") for (int k = 0; k < 2; ++k) dst[m][k] = *(const PG8_LAS bf16x8*)(lds + PG8_SA(b, h) + aoff + m * 2048 + k * 1024); } while (0)
#define PG8_LDB(dst, b, h) do { _Pragma("unroll") for (int n = 0; n < 2; ++n) _Pragma("unroll") for (int k = 0; k < 2; ++k) dst[n][k] = *(const PG8_LAS bf16x8*)(lds + PG8_SB(b, h) + boff + n * 2048 + k * 1024); } while (0)
#define PG8_MMA(ai, bj, At, Bt) do { __builtin_amdgcn_s_setprio(1); _Pragma("unroll") for (int m = 0; m < 4; ++m) _Pragma("unroll") for (int n = 0; n < 2; ++n) _Pragma("unroll") for (int k = 0; k < 2; ++k) \
        acc[ai][bj][m][n] = __builtin_amdgcn_mfma_f32_16x16x32_bf16(Bt[n][k], At[m][k], acc[ai][bj][m][n], 0, 0, 0); __builtin_amdgcn_s_setprio(0); } while (0)
#define PG8_WAIT_V(n) asm volatile("s_waitcnt vmcnt(" #n ")" ::: "memory")
#define PG8_WAIT_L(n) asm volatile("s_waitcnt lgkmcnt(" #n ")" ::: "memory")
#define PG8_BAR __builtin_amdgcn_s_barrier()
#define PG8_SCHED __builtin_amdgcn_sched_barrier(0)
    Unit cur, nxt; int ui = 0;
    if (!S.next(0, cur)) return;
    f32x4 acc[2][2][4][2];
#pragma unroll
    for (int a = 0; a < 2; ++a)
#pragma unroll
        for (int b = 0; b < 2; ++b)
#pragma unroll
            for (int m = 0; m < 4; ++m)
#pragma unroll
                for (int n = 0; n < 2; ++n) acc[a][b][m][n] = (f32x4){0.f, 0.f, 0.f, 0.f};
    bf16x8 At[4][2], B0[2][2], B1[2][2];
    const char* cA = (const char*)g.A + (size_t)cur.pm * tstep; const char* cB = (const char*)g.Bt + (size_t)cur.pn * tstep;
    S.a_ready(cur);
    if constexpr (SP2) {
        PG8_STAGE(PG8_SB(0, 0), cB, voffB); PG8_STAGE(PG8_SB(0, 1), cB + hstep, voffB); PG8_STAGE(PG8_SA(0, 0), cA, voffA); PG8_STAGE(PG8_SA(0, 1), cA + hstep, voffA);
        if (wr == 1) PG8_BAR;
        PG8_WAIT_V(2); PG8_BAR;
        PG8_STAGE(PG8_SB(1, 0), cB + kstep, voffB); PG8_STAGE(PG8_SA(1, 0), cA + kstep, voffA); PG8_STAGE(PG8_SB(1, 1), cB + hstep + kstep, voffB);
        PG8_WAIT_V(6); PG8_BAR;
    } else {
        PG8_STAGE(PG8_SB(0, 0), cB, voffB); PG8_STAGE(PG8_SA(0, 0), cA, voffA); PG8_STAGE(PG8_SB(0, 1), cB + hstep, voffB); PG8_STAGE(PG8_SA(0, 1), cA + hstep, voffA);
        if (wr == 1) PG8_BAR;
        PG8_WAIT_V(4); PG8_BAR;
        PG8_STAGE(PG8_SB(1, 0), cB + kstep, voffB); PG8_STAGE(PG8_SA(1, 0), cA + kstep, voffA); PG8_STAGE(PG8_SB(1, 1), cB + hstep + kstep, voffB);
        PG8_WAIT_V(6); PG8_BAR;
    }
    for (;;) {
        const bool has_next = S.next(ui + 1, nxt);
        const char* nA = has_next ? (const char*)g.A + (size_t)nxt.pm * tstep : cA; const char* nB = has_next ? (const char*)g.Bt + (size_t)nxt.pn * tstep : cB;
        for (int t = 0; t < nt; t += 2) {
            const bool last = (t == nt - 2);
            const char* a1 = cA + (size_t)(t + 1) * kstep;
            const char* a2 = last ? nA : cA + (size_t)(t + 2) * kstep; const char* b2 = last ? nB : cB + (size_t)(t + 2) * kstep;
            const char* a3 = a2 + kstep; const char* b3 = b2 + kstep;
            if (last && has_next) S.a_ready(nxt);
            if constexpr (SP2) {
            PG8_LDB(B0, 0, 0); PG8_LDB(B1, 0, 1); PG8_SCHED; PG8_LDA(At, 0, 0); PG8_STAGE(PG8_SA(1, 1), a1 + hstep, voffA);
            PG8_WAIT_V(8); PG8_WAIT_L(0); PG8_BAR; PG8_MMA(0, 0, At, B0); PG8_MMA(0, 1, At, B1); PG8_BAR; PG8_SCHED;
            PG8_LDA(At, 0, 1); PG8_STAGE(PG8_SB(0, 0), b2, voffB); PG8_STAGE(PG8_SB(0, 1), b2 + hstep, voffB); PG8_STAGE(PG8_SA(0, 0), a2, voffA);
            PG8_WAIT_V(8); PG8_WAIT_L(0); PG8_BAR; PG8_MMA(1, 0, At, B0); PG8_MMA(1, 1, At, B1); PG8_BAR; PG8_SCHED;
            PG8_LDB(B0, 1, 0); PG8_LDB(B1, 1, 1); PG8_SCHED; PG8_LDA(At, 1, 0); PG8_STAGE(PG8_SA(0, 1), a2 + hstep, voffA);
            PG8_WAIT_V(8); PG8_WAIT_L(0); PG8_BAR; PG8_MMA(0, 0, At, B0); PG8_MMA(0, 1, At, B1); PG8_BAR; PG8_SCHED;
            PG8_LDA(At, 1, 1); PG8_STAGE(PG8_SB(1, 0), b3, voffB); PG8_STAGE(PG8_SB(1, 1), b3 + hstep, voffB); PG8_STAGE(PG8_SA(1, 0), a3, voffA);
            PG8_WAIT_V(8); PG8_WAIT_L(0); PG8_BAR; PG8_MMA(1, 0, At, B0); PG8_MMA(1, 1, At, B1); PG8_BAR; PG8_SCHED;
            } else {
            PG8_LDB(B0, 0, 0); PG8_SCHED; PG8_LDA(At, 0, 0); PG8_STAGE(PG8_SA(1, 1), a1 + hstep, voffA);
            PG8_WAIT_L(8); PG8_BAR; PG8_WAIT_L(0); PG8_MMA(0, 0, At, B0); PG8_BAR; PG8_SCHED;
            PG8_LDB(B1, 0, 1); PG8_STAGE(PG8_SB(0, 0), b2, voffB);
            PG8_BAR; PG8_WAIT_L(0); PG8_MMA(0, 1, At, B1); PG8_BAR;
            PG8_LDA(At, 0, 1); PG8_STAGE(PG8_SA(0, 0), a2, voffA);
            PG8_BAR; PG8_WAIT_L(0); PG8_MMA(1, 0, At, B0); PG8_BAR; PG8_SCHED;
            PG8_STAGE(PG8_SB(0, 1), b2 + hstep, voffB);
            PG8_WAIT_V(6); PG8_BAR; PG8_MMA(1, 1, At, B1); PG8_BAR;
            PG8_LDB(B0, 1, 0); PG8_SCHED; PG8_LDA(At, 1, 0); PG8_STAGE(PG8_SA(0, 1), a2 + hstep, voffA);
            PG8_WAIT_L(8); PG8_BAR; PG8_WAIT_L(0); PG8_MMA(0, 0, At, B0); PG8_BAR; PG8_SCHED;
            PG8_LDB(B1, 1, 1); PG8_STAGE(PG8_SB(1, 0), b3, voffB);
            PG8_BAR; PG8_WAIT_L(0); PG8_MMA(0, 1, At, B1); PG8_BAR;
            PG8_LDA(At, 1, 1); PG8_STAGE(PG8_SA(1, 0), a3, voffA);
            PG8_BAR; PG8_WAIT_L(0); PG8_MMA(1, 0, At, B0); PG8_BAR; PG8_SCHED;
            PG8_STAGE(PG8_SB(1, 1), b3 + hstep, voffB);
            PG8_WAIT_V(6); PG8_BAR; PG8_MMA(1, 1, At, B1); PG8_BAR;
            }
        }
        if constexpr (ALIGN_EPI) { if (wr == 0) PG8_BAR; }
        if constexpr (!Epi::AFTER_DRAIN) { E(acc, cur, wr, wc, fr, fq); S.done(cur); }
        if (!has_next) break;
#pragma unroll
        for (int a = 0; a < 2; ++a)
#pragma unroll
            for (int b = 0; b < 2; ++b)
#pragma unroll
                for (int m = 0; m < 4; ++m)
#pragma unroll
                    for (int n = 0; n < 2; ++n) acc[a][b][m][n] = (f32x4){0.f, 0.f, 0.f, 0.f};
        cur = nxt; cA = nA; cB = nB; ++ui;
        if constexpr (ALIGN_EPI) { if (wr == 1) PG8_BAR; }
    }
    PG8_WAIT_V(0);
    if constexpr (!ALIGN_EPI) { if (wr == 0) PG8_BAR; }
    PG8_BAR;
    if constexpr (Epi::AFTER_DRAIN) { E.fused(acc, cur, wr, wc, fr, fq, lds, wid, lane); S.done(cur); }
#undef PG8_SA
#undef PG8_SB
#undef PG8_STAGE
#undef PG8_LDA
#undef PG8_LDB
#undef PG8_MMA
#undef PG8_WAIT_V
#undef PG8_WAIT_L
#undef PG8_BAR
#undef PG8_SCHED
}
}
constexpr int LD_P_ = 2816;
__device__ __forceinline__ unsigned pk2f(float lo, float hi) { return pg8::pk_bf16(lo, hi); }
#define GAS __attribute__((address_space(1)))
#define LAS __attribute__((address_space(3)))
typedef unsigned short bf16;
typedef unsigned v4u __attribute__((ext_vector_type(4)));
typedef unsigned v2u __attribute__((ext_vector_type(2)));
typedef float f32x4 __attribute__((ext_vector_type(4)));
typedef float f32x16 __attribute__((ext_vector_type(16)));
typedef short bf16x8 __attribute__((ext_vector_type(8)));
typedef short s16x4 __attribute__((ext_vector_type(4)));
constexpr int NWAVES = 8, NTHR = 512;
constexpr int DM = 1024, MP = 32768, MS = 512, MT = MP + MS, DFF = 2816, NUP = 5632, NPROJ = 2816, NLAYER = 2;
constexpr int SEQ = 4096, PAST = 4096, DSEQ = 32, NB_P = 8, NB_S = 16;
constexpr float ALPHA = 1.4142135623730951f, LN_EPS = 1e-5f, RMS_EPS = 1e-5f, LOG2E = 1.4426950408889634f;
constexpr float QSCALE = 0.125f * LOG2E;
constexpr int PC_U = 0, PC_UP = 256, PC_B = 512, PC_C = 768, PC_H = 1024, PC_Q = 1280, PC_K = 1792, PC_V = 2304;
constexpr size_t O_Y = 0, O_KP = 34078720, O_VP = 67633152, O_PLP = 101187584, O_CVP = 101249024, O_KS = 101257216, O_VS = 101781504, O_PLS = 102305792, O_CVS = 102428672, O_END = 102445056;
constexpr size_t MiB = 1u << 20;
constexpr size_t WS_XBAR = 65536;
constexpr size_t WS_CTL = 0, WS_LEFTP = 1 * MiB, WS_BT = 1 * MiB + 512 * 1024, WS_WUP = 2 * MiB, WS_WDN = 46 * MiB, WS_WIN = 68 * MiB, WS_WOUT = 79 * MiB,
                 WS_X = 84 * MiB, WS_XB = 214 * MiB, WS_HP = 279 * MiB, WS_MIX = 458 * MiB, WS_PART = 523 * MiB, WS_STATS = 548 * MiB, WS_CGBW = 552 * MiB, WS_END = 560 * MiB;
constexpr size_t SZ_WUP = (size_t)NUP * DM, SZ_WDN = (size_t)DM * DFF, SZ_WIN = (size_t)NPROJ * DM, SZ_WOUT = (size_t)DM * DM;
constexpr int RING_BYTES = 131072, MISC_OFF = RING_BYTES, LDS_BYTES = 155648;
constexpr int L_BT = MISC_OFF, L_Q = MISC_OFF + 2048, L_XB = MISC_OFF + 2304, L_TAB = MISC_OFF + 4096, L_FOLD = MISC_OFF + 12288;
constexpr int NPHASE = 2 + 8 * NLAYER;

struct Params { const float* in[18]; float* out; unsigned char* ws; int ph_lo, ph_hi; };

#define LDS_WAIT() asm volatile("s_waitcnt lgkmcnt(0)" ::: "memory")
__device__ __forceinline__ unsigned f2bf(float f) { unsigned u = __builtin_bit_cast(unsigned, f); return (u + 0x7fffu + ((u >> 16) & 1u)) >> 16; }
__device__ __forceinline__ unsigned pk2(float lo, float hi) { return f2bf(lo) | (f2bf(hi) << 16); }
__device__ __forceinline__ float bf2f(unsigned short h) { return __builtin_bit_cast(float, (unsigned)h << 16); }
__device__ __forceinline__ float bflo(unsigned w) { return __builtin_bit_cast(float, w << 16); }
__device__ __forceinline__ float bfhi(unsigned w) { return __builtin_bit_cast(float, w & 0xffff0000u); }
__device__ __forceinline__ float wave_sum(float v) {
#pragma unroll
    for (int o = 1; o < 64; o <<= 1) v += __shfl_xor(v, o);
    return v;
}

__device__ __forceinline__ void transpose_item(const float* W, int ldw, int K, bf16* WT, int k0, int srccol0, int dstrow0, LAS float* scr, int lane) {
    { const int kr = lane >> 3, c4 = (lane & 7) * 4; f32x4 v[8];
#pragma unroll
      for (int i = 0; i < 8; ++i) v[i] = *(const f32x4*)(W + (size_t)(k0 + 8 * i + kr) * ldw + srccol0 + c4);
#pragma unroll
      for (int i = 0; i < 8; ++i) { LAS float* d = scr + (8 * i + kr) * 33 + c4; d[0] = v[i].x; d[1] = v[i].y; d[2] = v[i].z; d[3] = v[i].w; } }
    LDS_WAIT(); asm volatile("" ::: "memory");
    const int c = lane & 7;
#pragma unroll
    for (int j = 0; j < 4; ++j) { const int n = (lane >> 3) + 8 * j; const LAS float* s = scr + (8 * c) * 33 + n;
        v4u o; o.x = pk2(s[0 * 33], s[1 * 33]); o.y = pk2(s[2 * 33], s[3 * 33]); o.z = pk2(s[4 * 33], s[5 * 33]); o.w = pk2(s[6 * 33], s[7 * 33]);
        *(v4u*)(WT + (size_t)(dstrow0 + n) * K + k0 + 8 * c) = o; }
    LDS_WAIT(); asm volatile("" ::: "memory");
}
__device__ __forceinline__ int t5_bucket(int rel) {
    const int nb = 16, max_exact = 8; int ret = rel > 0 ? nb : 0; const int n = rel < 0 ? -rel : rel;
    if (n < max_exact) return ret + n;
    int j = 0; const long n2 = (long)n * n;
    while (j < 7 && (64L << (j + 1)) <= n2) ++j;
    return ret + max_exact + j;
}
__device__ __forceinline__ void prologue(const Params& P, LAS unsigned char* lds, int G) {
    const int tid = tid_opaque(), lane = tid & 63, wave = __builtin_amdgcn_readfirstlane(tid >> 6);
    const int gw = blockIdx.x * NWAVES + wave, NGW = G * NWAVES;
    unsigned char* ws = P.ws;
    LAS float* scr = (LAS float*)(lds + wave * 16384);
    if (blockIdx.x == 0 && tid < 256) ((unsigned*)(ws + WS_CTL))[tid] = 0u;
    if (blockIdx.x == 0 && wave == 1) {
        for (int l = 0; l < NLAYER; ++l) { const float* dl = P.in[15] + l * 256;
            const float a = wave_sum(dl[lane] * dl[64 + lane]), b = wave_sum(dl[128 + lane] * dl[192 + lane]);
            const float lam_init = 0.8f - 0.6f * expf(-0.3f * (float)l);
            if (lane == 0) ((float*)(ws + WS_CTL))[256 + l] = expf(a) - expf(b) + lam_init; }
    }
    if (blockIdx.x == 1) {
        for (int e = tid; e < 4 * 256; e += NTHR) { const int h = e >> 8, i = e & 255; ((float*)(ws + WS_BT))[e] = P.in[17][t5_bucket(i - 192) * 4 + h] * LOG2E; }
    }
    constexpr int I_UP = 16 * 176, I_DN = 44 * 32, I_IN = 16 * 88, I_OUT = 16 * 32;
    constexpr int NITEMS = 4 * I_UP + 4 * I_DN + 2 * I_IN + 2 * I_OUT;
    for (int it = gw; it < NITEMS; it += NGW) {
        int r = it;
        if (r < 4 * I_UP) { const int mi = r / I_UP, q = r % I_UP, kb = q / 176, nb = q % 176; const int n0 = nb * 32, t = n0 >> 8, c = n0 & 255;
            const int src0 = (c < 128) ? 128 * t + c : DFF + 128 * t + (c - 128);
            transpose_item(P.in[8] + (size_t)mi * DM * NUP, NUP, DM, (bf16*)(ws + WS_WUP) + (size_t)mi * SZ_WUP, kb * 64, src0, n0, scr, lane); continue; }
        r -= 4 * I_UP;
        if (r < 4 * I_DN) { const int mi = r / I_DN, q = r % I_DN, kb = q / 32, nb = q % 32;
            transpose_item(P.in[9] + (size_t)mi * DFF * DM, DM, DFF, (bf16*)(ws + WS_WDN) + (size_t)mi * SZ_WDN, kb * 64, nb * 32, nb * 32, scr, lane); continue; }
        r -= 4 * I_DN;
        if (r < 2 * I_IN) { const int mi = r / I_IN, q = r % I_IN, kb = q / 88, nb = q % 88; const int n0 = nb * 32;
            if (n0 >= 256 && n0 < 512) continue;
            const int src0 = n0 < 256 ? n0 : n0 - 256;
            transpose_item(P.in[10] + (size_t)mi * DM * 2560, 2560, DM, (bf16*)(ws + WS_WIN) + (size_t)mi * SZ_WIN, kb * 64, src0, n0, scr, lane); continue; }
        r -= 2 * I_IN;
        { const int mi = r / I_OUT, q = r % I_OUT, kb = q / 32, nb = q % 32;
            transpose_item(P.in[11] + (size_t)mi * DM * DM, DM, DM, (bf16*)(ws + WS_WOUT) + (size_t)mi * SZ_WOUT, kb * 64, nb * 32, nb * 32, scr, lane); }
    }
    for (int it = gw; it < NLAYER * 4 * 128; it += NGW) {
        const int l = it >> 9, g = (it >> 7) & 3, k0 = (it & 127) * 8;
        const float* pw = P.in[12] + (size_t)(l * 4 + g) * 4096; const float* wi = P.in[10] + (size_t)l * DM * 2560 + g * 64;
        float a[8];
#pragma unroll
        for (int j = 0; j < 8; ++j) a[j] = 0.f;
        for (int c = 0; c < 64; ++c) { const float w = pw[c * 64 + lane];
#pragma unroll
            for (int j = 0; j < 8; ++j) a[j] += wi[(size_t)(k0 + j) * 2560 + c] * w; }
        const float sc = P.in[13][l * 256 + g * 64 + lane];
        v4u o; o.x = pk2(a[0] * sc, a[1] * sc); o.y = pk2(a[2] * sc, a[3] * sc); o.z = pk2(a[4] * sc, a[5] * sc); o.w = pk2(a[6] * sc, a[7] * sc);
        *(v4u*)((bf16*)(ws + WS_WIN) + (size_t)l * SZ_WIN + (size_t)(256 + g * 64 + lane) * DM + k0) = o;
    }
    for (int it = gw; it < NLAYER * NB_S * 15 * 4; it += NGW) {
        const int g = it & 3, rj = it >> 2, l = rj / (NB_S * 15);
        const float* pw = P.in[12] + (size_t)(l * 4 + g) * 4096; const float* st = P.in[4] + (size_t)rj * 256 + g * 64;
        float a = 0.f;
        for (int c = 0; c < 64; ++c) a += st[c] * pw[c * 64 + lane];
        ((float*)(ws + WS_LEFTP))[(size_t)rj * 256 + g * 64 + lane] = a * P.in[13][l * 256 + g * 64 + lane];
    }
    {
        LAS float* red = (LAS float*)lds;
        __syncthreads();
        for (int it = blockIdx.x; it < 5 * 22; it += G) {
            const int ci = it / 22, nb = it % 22, c = ci + 1, l = c / 3, kind = c % 3;
            if (kind == 1 && (nb >= 11 || nb == 1)) continue;
            const int lni = kind == 0 ? (l - 1) * 3 + 2 : kind == 1 ? l * 3 : l * 3 + 1;
            const float* gvec = P.in[6] + (size_t)lni * DM; const float* bvec = P.in[7] + (size_t)lni * DM;
            const float* W; int ldw, src; const int n0 = nb * 256, cc = lane * 4;
            if (kind == 1) { W = P.in[10] + (size_t)l * DM * 2560; ldw = 2560; src = (nb == 0 ? 0 : n0 - 256) + cc; }
            else { W = P.in[8] + (size_t)(l * 2 + (kind == 2)) * DM * NUP; ldw = NUP; src = cc < 128 ? 128 * nb + cc : DFF + 128 * nb + (cc - 128); }
            f32x4 ag = {0.f, 0.f, 0.f, 0.f}, ab = {0.f, 0.f, 0.f, 0.f};
            { const float* wp = W + (size_t)(wave * 128) * ldw + src;
#pragma unroll 16
              for (int k = 0; k < 128; ++k) { const f32x4 w = *(const f32x4*)(wp + (size_t)k * ldw); ag += gvec[wave * 128 + k] * w; ab += bvec[wave * 128 + k] * w; } }
#pragma unroll
            for (int e = 0; e < 4; ++e) { red[((wave * 256) + cc + e) * 2] = ag[e]; red[((wave * 256) + cc + e) * 2 + 1] = ab[e]; }
            __syncthreads();
            float* cgp = (float*)(ws + WS_CGBW) + (size_t)c * 2 * NUP;
            LAS float* tg = red + 4096;
            if (tid < 256) { float sg = 0.f, sb = 0.f;
#pragma unroll
                for (int w8 = 0; w8 < 8; ++w8) { sg += red[(w8 * 256 + tid) * 2]; sb += red[(w8 * 256 + tid) * 2 + 1]; }
                cgp[n0 + tid] = sg; cgp[NUP + n0 + tid] = sb; tg[tid * 2] = sg; tg[tid * 2 + 1] = sb; }
            __syncthreads();
            if (kind == 1 && nb == 0 && tid < 256) {
                const int gi = tid >> 6, d = tid & 63; const float* pw = P.in[12] + (size_t)(l * 4 + gi) * 4096; float pg = 0.f, pb = 0.f;
                for (int q = 0; q < 64; ++q) { const float w = pw[q * 64 + d]; pg += tg[(gi * 64 + q) * 2] * w; pb += tg[(gi * 64 + q) * 2 + 1] * w; }
                const float sc = P.in[13][l * 256 + tid];
                cgp[256 + tid] = pg * sc; cgp[NUP + 256 + tid] = pb * sc;
            }
            __syncthreads();
        }
    }
    for (int m = gw; m < MT; m += 2 * NGW) {
        const int m2 = m + NGW; const bool h2 = m2 < MT;
        const float* src = (m < MP) ? P.in[0] + (size_t)m * DM : P.in[1] + (size_t)(m - MP) * DM;
        const float* src2 = h2 ? ((m2 < MP) ? P.in[0] + (size_t)m2 * DM : P.in[1] + (size_t)(m2 - MP) * DM) : src;
        const f32x4* xr = (const f32x4*)src + lane; const f32x4* xr2 = (const f32x4*)src2 + lane;
        f32x4 va[4], vb[4];
#pragma unroll
        for (int j = 0; j < 4; ++j) { va[j] = xr[64 * j]; vb[j] = xr2[64 * j]; }
        v2u* bo = (v2u*)((bf16*)(ws + WS_XB) + (size_t)m * DM) + lane; v2u* bo2 = (v2u*)((bf16*)(ws + WS_XB) + (size_t)m2 * DM) + lane;
#pragma unroll
        for (int j = 0; j < 4; ++j) { v2u w; w.x = pk2(va[j].x, va[j].y); w.y = pk2(va[j].z, va[j].w); bo[64 * j] = w;
            if (h2) { v2u z; z.x = pk2(vb[j].x, vb[j].y); z.y = pk2(vb[j].z, vb[j].w); bo2[64 * j] = z; } }
    }
}
__device__ __forceinline__ void ln_pass(const Params& P, int gw0, int NGW, int row0, int row1, const float* g, const float* b, float* dst, bool write_xb) {
    const int tid = tid_opaque(), lane = tid & 63, wave = __builtin_amdgcn_readfirstlane(tid >> 6);
    const int gw = gw0 + wave;
    f32x4 gv[4], bv[4];
#pragma unroll
    for (int j = 0; j < 4; ++j) { gv[j] = ((const f32x4*)g)[lane + 64 * j]; bv[j] = ((const f32x4*)b)[lane + 64 * j]; }
    float* stats = (float*)(P.ws + WS_STATS);
    for (int m = row0 + gw; m < row1; m += NGW) {
        const f32x4* xr = (const f32x4*)((const float*)(P.ws + WS_X) + (size_t)m * DM) + lane;
        f32x4 v[4]; float s = 0.f;
#pragma unroll
        for (int j = 0; j < 4; ++j) { v[j] = xr[64 * j]; s += (v[j].x + v[j].y) + (v[j].z + v[j].w); }
        const float mean = wave_sum(s) * (1.f / DM); float s2 = 0.f;
#pragma unroll
        for (int j = 0; j < 4; ++j) { v[j] = v[j] - mean; s2 += (v[j].x * v[j].x + v[j].y * v[j].y) + (v[j].z * v[j].z + v[j].w * v[j].w); }
        const float rstd = 1.f / sqrtf(wave_sum(s2) * (1.f / DM) + LN_EPS);
        if (dst) { f32x4* xo = (f32x4*)(dst + (size_t)m * DM) + lane;
#pragma unroll
            for (int j = 0; j < 4; ++j) xo[64 * j] = v[j] * rstd * gv[j] + bv[j]; }
        if (write_xb) { v2u* bo = (v2u*)((bf16*)(P.ws + WS_XB) + (size_t)m * DM) + lane;
            if (lane == 0) { stats[2 * m] = mean; stats[2 * m + 1] = rstd; }
#pragma unroll
            for (int j = 0; j < 4; ++j) { const f32x4 o = v[j] * rstd * gv[j] + bv[j]; v2u w; w.x = pk2(o.x, o.y); w.y = pk2(o.z, o.w); bo[64 * j] = w; } }
    }
}

__device__ __forceinline__ void final_ln(const Params& P, int G, const float* sp, const float* g, const float* b, float* dst) {
    const int tid = tid_opaque(), lane = tid & 63, wave = __builtin_amdgcn_readfirstlane(tid >> 6);
    const int gw = blockIdx.x * NWAVES + wave, NGW = G * NWAVES;
    f32x4 gv[4], bv[4];
#pragma unroll
    for (int j = 0; j < 4; ++j) { gv[j] = ((const f32x4*)g)[lane + 64 * j]; bv[j] = ((const f32x4*)b)[lane + 64 * j]; }
    for (int m = gw; m < MT; m += NGW) {
        const f32x4 a = *(const f32x4*)(sp + (size_t)m * 8), c = *(const f32x4*)(sp + (size_t)m * 8 + 4);
        const float s1 = (a[0] + a[2]) + (c[0] + c[2]), s2 = (a[1] + a[3]) + (c[1] + c[3]);
        const float mean = s1 * (1.0f / DM), var = s2 * (1.0f / DM) - mean * mean, rstd = 1.0f / sqrtf(var + LN_EPS);
        const v2u* xb = (const v2u*)((const bf16*)(P.ws + WS_XB) + (size_t)m * DM) + lane;
        f32x4* xo = (f32x4*)(dst + (size_t)m * DM) + lane;
#pragma unroll
        for (int j = 0; j < 4; ++j) { const v2u w = xb[64 * j]; const f32x4 v = {bflo(w.x), bfhi(w.x), bflo(w.y), bfhi(w.y)};
            xo[64 * j] = (v - mean * gv[j]) * rstd + bv[j]; }
    }
}
#define RLX_AGENT __ATOMIC_RELAXED, __HIP_MEMORY_SCOPE_AGENT
#define LDS_WAIT() asm volatile("s_waitcnt lgkmcnt(0)" ::: "memory")
#define VM_WAIT() asm volatile("s_waitcnt vmcnt(0)" ::: "memory")
#define XB_TMO      128
#define XB_XCNT(j)  (256  + 64 * (j))
#define XB_XSUB(j)  (1280 + 64 * (j))
#define XB_XGEN(j)  (2304 + 64 * (j))
#define XB_TOP      3328
#define XB_TOPGEN   3392
#define XCD_BAR_WORDS 3456
#define XB_SPIN_CAP (1u << 18)

__device__ __forceinline__ unsigned xb_ld(unsigned* p)              { return __hip_atomic_load(p, __ATOMIC_RELAXED, __HIP_MEMORY_SCOPE_AGENT); }
__device__ __forceinline__ unsigned xb_add(unsigned* p, unsigned v) { return __hip_atomic_fetch_add(p, v, __ATOMIC_RELAXED, __HIP_MEMORY_SCOPE_AGENT); }
__device__ __forceinline__ unsigned xb_xcc_id() { return (unsigned)__builtin_amdgcn_s_getreg((3 << 11) | 20) & 0xFu; }
#define XB_SPIN(cond, bar) do { unsigned _sp = 0; while (cond) { __builtin_amdgcn_s_sleep(1); \
    if ((++_sp & 255u) == 0u) { if (xb_ld(&(bar)[XB_TMO])) break; if (_sp > XB_SPIN_CAP) { atomicAdd(&(bar)[XB_TMO], 1u); break; } } } } while (0)

struct XcdBarrier {
    unsigned* bar; unsigned x;
    volatile LAS unsigned* st;
};

__device__ __forceinline__ XcdBarrier xcd_barrier_post(unsigned* bar, volatile LAS unsigned* st) {
    XcdBarrier b; b.bar = bar; b.x = xb_xcc_id(); b.st = st;
    if (threadIdx.x == 0) (void)xb_add(&bar[XB_XCNT(b.x)], 1u);
    return b;
}
__device__ __forceinline__ void xcd_barrier_complete(unsigned* bar, unsigned x, unsigned& nloc, unsigned& nx) {
    const unsigned G = gridDim.x * gridDim.y * gridDim.z;
    unsigned sum, cnt, mine, sp = 0u;
    for (;;) {
        sum = 0u; cnt = 0u; mine = 0u;
#pragma unroll
        for (unsigned j = 0; j < 16; ++j) { const unsigned c = xb_ld(&bar[XB_XCNT(j)]); sum += c; cnt += (c > 0u) ? 1u : 0u; mine = (j == x) ? c : mine; }
        if (sum == G) break;
        __builtin_amdgcn_s_sleep(1);
        if ((++sp & 255u) == 0u) { if (xb_ld(&bar[XB_TMO])) break; if (sp > XB_SPIN_CAP) { atomicAdd(&bar[XB_TMO], 1u); break; } }
    }
    nloc = mine > 0u ? mine : 1u; nx = cnt > 0u ? cnt : 1u;
}

__device__ __forceinline__ void xcd_barrier(const XcdBarrier& b) {
    asm volatile("s_waitcnt vmcnt(0)" ::: "memory");
    __syncthreads();
    if (threadIdx.x == 0) {
        unsigned* bar = b.bar;
        __builtin_amdgcn_s_waitcnt(0);
        unsigned nloc = b.st[0], nx = b.st[1];
        if (nloc == 0u) { xcd_barrier_complete(bar, b.x, nloc, nx); b.st[0] = nloc; b.st[1] = nx; }
        const unsigned old = xb_add(&bar[XB_XSUB(b.x)], 1u);
        const unsigned gen = old / nloc;
        if (old + 1u == (gen + 1u) * nloc) {
            __builtin_amdgcn_fence(__ATOMIC_RELEASE, "agent");
            asm volatile("s_waitcnt vmcnt(0)" ::: "memory");
            const unsigned og = xb_add(&bar[XB_TOP], 1u);
            const unsigned tg = og / nx;
            if (og + 1u == (tg + 1u) * nx) xb_add(&bar[XB_TOPGEN], 1u);
            else XB_SPIN(xb_ld(&bar[XB_TOPGEN]) == tg, bar);
            __builtin_amdgcn_fence(__ATOMIC_ACQUIRE, "agent");
            xb_add(&bar[XB_XGEN(b.x)], 1u);
            asm volatile("s_waitcnt vmcnt(0)" ::: "memory");
        } else {
            XB_SPIN(xb_ld(&bar[XB_XGEN(b.x)]) == gen, bar);
            __builtin_amdgcn_fence(__ATOMIC_ACQUIRE, "agent");
            asm volatile("s_waitcnt vmcnt(0)" ::: "memory");
        }
    }
    __syncthreads();
}
__device__ __forceinline__ int crow(int r, int hi) { return (r & 3) + 8 * (r >> 2) + 4 * hi; }
__device__ __forceinline__ unsigned off_b(unsigned row, unsigned ch) { return 256u * row + 16u * (ch ^ (((row & 3) << 2) | ((row >> 2) & 3))); }
typedef short v4i16_t __attribute__((ext_vector_type(4)));
__device__ __forceinline__ s16x4 vtr(LAS unsigned char* p) { return __builtin_bit_cast(s16x4, __builtin_amdgcn_ds_read_tr16_b64_v4i16((LAS v4i16_t*)p)); }
constexpr float NEG_BIG = -1e30f;
__device__ __forceinline__ float max3f(float a, float b, float c) { float r; asm("v_max3_f32 %0, %1, %2, %3" : "=v"(r) : "v"(a), "v"(b), "v"(c)); return r; }
constexpr int KT_NEW = 64;
__device__ __forceinline__ void attn_finalize(LAS unsigned char* lds, const Params& P, int l, int h, size_t grow, int comp, int rg, int lane, bool active, f32x16 (&O)[4], float l_tot) {
    const int hi = lane >> 5;
    const float lam = ((const float*)(P.ws + WS_CTL))[256 + l];
    const float lam_init = 0.8f - 0.6f * expf(-0.3f * (float)l);
    const float inv = active ? 1.0f / l_tot : 0.f;
    LAS float* EX = (LAS float*)(lds + 65536 + rg * 16384);
    if (comp == 1 && active) {
        const float f = inv * lam;
#pragma unroll
        for (int c = 0; c < 4; ++c)
#pragma unroll
            for (int r = 0; r < 16; ++r) EX[(c * 16 + r) * 64 + lane] = O[c][r] * f;
    }
    __syncthreads();
    if (comp == 0 && active) {
        float ss = 0.f;
#pragma unroll
        for (int c = 0; c < 4; ++c)
#pragma unroll
            for (int r = 0; r < 16; ++r) { const float o = O[c][r] * inv - EX[(c * 16 + r) * 64 + lane]; O[c][r] = o; ss += o * o; }
        ss += __shfl_xor(ss, 32);
        const float rms = (1.0f - lam_init) / sqrtf(ss * (1.0f / 128.0f) + RMS_EPS);
        const float* sg = P.in[16] + l * 128;
        bf16* mp = (bf16*)(P.ws + WS_MIX) + grow * DM + 512 + h * 128;
#pragma unroll
        for (int c = 0; c < 4; ++c)
#pragma unroll
            for (int g4 = 0; g4 < 4; ++g4) { const int d = 32 * c + 8 * g4 + 4 * hi; const f32x4 gg = *(const f32x4*)(sg + d);
                v2u w; w.x = pk2f(O[c][4 * g4 + 0] * rms * gg.x, O[c][4 * g4 + 1] * rms * gg.y); w.y = pk2f(O[c][4 * g4 + 2] * rms * gg.z, O[c][4 * g4 + 3] * rms * gg.w);
                *(v2u*)(mp + d) = w; }
    }
    __syncthreads();
}
constexpr int PART_STRIDE = 64 * 64 + 128;
__device__ __forceinline__ void attn_combine(LAS unsigned char* lds, const Params& P, int l, int b, int h) {
    const int tid = tid_opaque(), lane = tid & 63, wid = __builtin_amdgcn_readfirstlane(tid >> 6), comp = wid & 1, rg = wid >> 1, r32 = lane & 31;
    const bool active = rg == 0;
    f32x16 O[4];
#pragma unroll
    for (int c = 0; c < 4; ++c) O[c] = (f32x16){};
    float l_tot = 1.f;
    if (active) {
        const float* pb = (const float*)(P.ws + WS_PART) + (size_t)((((l * NB_S + b) * 4 + h) * 4) * 2 + comp) * PART_STRIDE;
        float m[4], mstar = NEG_BIG;
#pragma unroll
        for (int sp = 0; sp < 4; ++sp) { m[sp] = pb[(size_t)sp * 2 * PART_STRIDE + 4096 + lane]; mstar = fmaxf(mstar, m[sp]); }
        l_tot = 0.f;
#pragma unroll
        for (int sp = 0; sp < 4; ++sp) { const float f = __builtin_amdgcn_exp2f(m[sp] - mstar); const float* q = pb + (size_t)sp * 2 * PART_STRIDE;
            l_tot += q[4096 + 64 + lane] * f;
#pragma unroll
            for (int c = 0; c < 4; ++c)
#pragma unroll
                for (int r = 0; r < 16; ++r) O[c][r] += q[(c * 16 + r) * 64 + lane] * f; }
    }
    attn_finalize(lds, P, l, h, (size_t)(MP + b * DSEQ + r32), comp, rg, lane, active, O, l_tot);
}
template <bool SAMPLE>
__device__ __forceinline__ void attn_unit(LAS unsigned char* lds, const Params& P, int l, int b, int h, int qb) {
    const int tid = tid_opaque(), lane = tid & 63, wid = __builtin_amdgcn_readfirstlane(tid >> 6), comp = wid & 1, rg = wid >> 1, r32 = lane & 31, hi = lane >> 5;
    const bf16* PROJ = (const bf16*)(P.ws + WS_HP);
    const int KT0 = 0, NT = SAMPLE ? 65 : 2 * qb + 2;
    const int q0 = SAMPLE ? 0 : qb * 128 + rg * 32;
    const int qpos0 = SAMPLE ? PAST : q0;
    const int nt_w = SAMPLE ? NT : (q0 >> 6) + 1;
    const size_t grow = SAMPLE ? (size_t)(MP + b * DSEQ + r32) : (size_t)(b * SEQ + q0 + r32);
    bf16x8 qf[4];
#pragma unroll
    for (int ks = 0; ks < 4; ++ks) qf[ks] = *(const bf16x8*)(PROJ + grow * LD_P_ + PC_Q + h * 128 + comp * 64 + ks * 16 + hi * 8);
    unsigned kaddr[4], vaddr[4][2];
    { const unsigned xk = ((r32 & 3) << 2) | ((r32 >> 2) & 3);
#pragma unroll
      for (int ks = 0; ks < 4; ++ks) kaddr[ks] = 256u * r32 + 16u * ((unsigned)(8 * comp + 2 * ks + hi) ^ xk);
      const unsigned blk = (lane >> 4) & 1, q = (lane & 15) >> 2, p = lane & 3;
#pragma unroll
      for (int c = 0; c < 4; ++c)
#pragma unroll
          for (int t = 0; t < 2; ++t) vaddr[c][t] = off_b(8 * t + 4 * hi + q, 4 * c + 2 * blk + (p >> 1)) + 8 * (p & 1); }
    const int crow0 = tid >> 4, cch = tid & 15;
    const unsigned sdst0 = off_b(crow0, cch), sdst1 = off_b(crow0 + 32, cch);
    v4u stg[4];
    f32x4 raw[8];
    const float* ckb = SAMPLE ? P.in[2] + ((size_t)(l * NB_S + b) * PAST * 4 + h) * 128 + cch * 8 : nullptr;
    const float* cvb = SAMPLE ? P.in[3] + ((size_t)(l * NB_S + b) * PAST * 4 + h) * 128 + cch * 8 : nullptr;
    const float* nkb = SAMPLE ? P.out + O_KS + ((size_t)(l * NB_S + b) * DSEQ * 4 + h) * 128 + cch * 8 : nullptr;
    const float* nvb = SAMPLE ? P.out + O_VS + ((size_t)(l * NB_S + b) * DSEQ * 4 + h) * 128 + cch * 8 : nullptr;
    const bf16* pkb = PROJ + (size_t)(b * SEQ) * LD_P_ + PC_K + h * 128 + cch * 8;
    const bf16* pvb = PROJ + (size_t)(b * SEQ) * LD_P_ + PC_V + h * 128 + cch * 8;
#define ATT_LOAD(kt) do { \
    if (SAMPLE) { _Pragma("unroll") for (int i_ = 0; i_ < 2; ++i_) { const int row_ = crow0 + 32 * i_; \
            if ((kt) < 64) { const float* a_ = ckb + (size_t)((kt) * 64 + row_) * 512; const float* b_ = cvb + (size_t)((kt) * 64 + row_) * 512; \
                raw[4 * i_ + 0] = *(const f32x4*)a_; raw[4 * i_ + 1] = *(const f32x4*)(a_ + 4); raw[4 * i_ + 2] = *(const f32x4*)b_; raw[4 * i_ + 3] = *(const f32x4*)(b_ + 4); } \
            else if (row_ < DSEQ) { const float* a_ = nkb + (size_t)row_ * 512; const float* b_ = nvb + (size_t)row_ * 512; \
                raw[4 * i_ + 0] = *(const f32x4*)a_; raw[4 * i_ + 1] = *(const f32x4*)(a_ + 4); raw[4 * i_ + 2] = *(const f32x4*)b_; raw[4 * i_ + 3] = *(const f32x4*)(b_ + 4); } \
            else { raw[4 * i_ + 0] = (f32x4){0.f, 0.f, 0.f, 0.f}; raw[4 * i_ + 1] = (f32x4){0.f, 0.f, 0.f, 0.f}; raw[4 * i_ + 2] = (f32x4){0.f, 0.f, 0.f, 0.f}; raw[4 * i_ + 3] = (f32x4){0.f, 0.f, 0.f, 0.f}; } } } \
    else { _Pragma("unroll") for (int i_ = 0; i_ < 2; ++i_) { const size_t ro_ = (size_t)((kt) * 64 + crow0 + 32 * i_) * LD_P_; \
            stg[2 * i_ + 0] = *(const v4u*)(pkb + ro_); stg[2 * i_ + 1] = *(const v4u*)(pvb + ro_); } } } while (0)
#define CVT8F(lo_, hi_) ((v4u){pk2f((lo_).x, (lo_).y), pk2f((lo_).z, (lo_).w), pk2f((hi_).x, (hi_).y), pk2f((hi_).z, (hi_).w)})
#define ATT_STORE(s) do { LAS unsigned char* kb_ = lds + (s) * 32768; \
    if (SAMPLE) { stg[0] = CVT8F(raw[0], raw[1]); stg[1] = CVT8F(raw[2], raw[3]); stg[2] = CVT8F(raw[4], raw[5]); stg[3] = CVT8F(raw[6], raw[7]); } \
    *(LAS v4u*)(kb_ + sdst0) = stg[0]; *(LAS v4u*)(kb_ + 16384 + sdst0) = stg[1]; *(LAS v4u*)(kb_ + sdst1) = stg[2]; *(LAS v4u*)(kb_ + 16384 + sdst1) = stg[3]; } while (0)
    const LAS float* BT = (const LAS float*)(lds + L_BT);
    if (tid < 256) ((LAS float*)(lds + L_BT))[tid] = ((const float*)(P.ws + WS_BT))[h * 256 + tid];
    const float cfar = ((const float*)(P.ws + WS_BT))[h * 256];
    f32x16 O[4];
#pragma unroll
    for (int c = 0; c < 4; ++c) O[c] = (f32x16){};
    float m_run = NEG_BIG, l_run = 0.f;
    ATT_LOAD(KT0); ATT_STORE(0);
    __syncthreads();
    for (int kt = KT0; kt < NT; ++kt) {
        if (kt + 1 < NT) ATT_LOAD(kt + 1);
        if (kt < nt_w && (!SAMPLE || (kt & 3) == rg)) {
            LAS unsigned char* Kb = lds + ((kt - KT0) & 1) * 32768; LAS unsigned char* Vb = Kb + 16384;
            const bool far = (qpos0 - (kt * 64 + 63)) >= 91;
            const float ini = far ? cfar : 0.f;
            f32x16 p0, p1;
#pragma unroll
            for (int r = 0; r < 16; ++r) { p0[r] = ini; p1[r] = ini; }
            {
                bf16x8 kf[8];
#pragma unroll
                for (int ks = 0; ks < 4; ++ks) { kf[2 * ks] = *(const LAS bf16x8*)(Kb + kaddr[ks]); kf[2 * ks + 1] = *(const LAS bf16x8*)(Kb + kaddr[ks] + 8192); }
                __builtin_amdgcn_sched_barrier(0);
#pragma unroll
                for (int ks = 0; ks < 4; ++ks) {
                    p0 = __builtin_amdgcn_mfma_f32_32x32x16_bf16(kf[2 * ks], qf[ks], p0, 0, 0, 0);
                    p1 = __builtin_amdgcn_mfma_f32_32x32x16_bf16(kf[2 * ks + 1], qf[ks], p1, 0, 0, 0);
                }
            }
            s16x4 va[8], vb[8];
#define VLOAD(dst, s_) do { _Pragma("unroll") for (int c_ = 0; c_ < 4; ++c_) { dst[2 * c_] = vtr(Vb + vaddr[c_][0] + 4096 * (s_)); dst[2 * c_ + 1] = vtr(Vb + vaddr[c_][1] + 4096 * (s_)); } } while (0)
#define VFRAG(src, c_) ((bf16x8){src[2 * (c_)][0], src[2 * (c_)][1], src[2 * (c_)][2], src[2 * (c_)][3], src[2 * (c_) + 1][0], src[2 * (c_) + 1][1], src[2 * (c_) + 1][2], src[2 * (c_) + 1][3]})
            VLOAD(va, 0);
            __builtin_amdgcn_sched_barrier(0);
            if (!far) { const int ib = kt * 64 - (qpos0 + r32) + 192 + 4 * hi;
#pragma unroll
                for (int r = 0; r < 16; ++r) { const int o = (r & 3) + 8 * (r >> 2); p0[r] += BT[ib + o]; p1[r] += BT[ib + o + 32]; } }
            if (SAMPLE && kt == KT_NEW) {
#pragma unroll
                for (int r = 0; r < 16; ++r) p1[r] = NEG_BIG; }
            float mx = NEG_BIG, mx2 = NEG_BIG;
#pragma unroll
            for (int r = 0; r < 16; r += 2) { mx = max3f(mx, p0[r], p0[r + 1]); mx2 = max3f(mx2, p1[r], p1[r + 1]); }
            mx = fmaxf(mx, mx2);
            mx = fmaxf(mx, __shfl_xor(mx, 32));
            const float m_new = fmaxf(m_run, mx), alpha = __builtin_amdgcn_exp2f(m_run - m_new);
            const bool resc = m_new > m_run;
            m_run = m_new;
            float ls = 0.f;
#pragma unroll
            for (int r = 0; r < 16; ++r) { p0[r] = __builtin_amdgcn_exp2f(p0[r] - m_new); p1[r] = __builtin_amdgcn_exp2f(p1[r] - m_new); ls += p0[r] + p1[r]; }
            l_run = l_run * alpha + ls;
            if (__any(resc)) {
#pragma unroll
                for (int c = 0; c < 4; ++c)
#pragma unroll
                    for (int r = 0; r < 16; ++r) O[c][r] *= alpha;
            }
            v4u pw[4];
            pw[0] = (v4u){pk2f(p0[0], p0[1]), pk2f(p0[2], p0[3]), pk2f(p0[4], p0[5]), pk2f(p0[6], p0[7])};
            pw[1] = (v4u){pk2f(p0[8], p0[9]), pk2f(p0[10], p0[11]), pk2f(p0[12], p0[13]), pk2f(p0[14], p0[15])};
            pw[2] = (v4u){pk2f(p1[0], p1[1]), pk2f(p1[2], p1[3]), pk2f(p1[4], p1[5]), pk2f(p1[6], p1[7])};
            pw[3] = (v4u){pk2f(p1[8], p1[9]), pk2f(p1[10], p1[11]), pk2f(p1[12], p1[13]), pk2f(p1[14], p1[15])};
            __builtin_amdgcn_sched_barrier(0);
#define PVSTEP(cur, nxt, s_) do { if ((s_) < 3) VLOAD(nxt, (s_) + 1); __builtin_amdgcn_sched_barrier(0); \
                const bf16x8 pf_ = __builtin_bit_cast(bf16x8, pw[s_]); \
                _Pragma("unroll") for (int c_ = 0; c_ < 4; ++c_) O[c_] = __builtin_amdgcn_mfma_f32_32x32x16_bf16(VFRAG(cur, c_), pf_, O[c_], 0, 0, 0); \
                __builtin_amdgcn_sched_barrier(0); } while (0)
            PVSTEP(va, vb, 0); PVSTEP(vb, va, 1); PVSTEP(va, vb, 2); PVSTEP(vb, va, 3);
#undef PVSTEP
#undef VLOAD
#undef VFRAG
        }
        if (kt + 1 < NT) ATT_STORE((kt + 1 - KT0) & 1);
        __syncthreads();
    }
#undef ATT_LOAD
#undef ATT_STORE
#undef CVT8F
    const bool active = true;
    const float l_tot = l_run + __shfl_xor(l_run, 32);
    if (SAMPLE) {
        if (active) { float* pb = (float*)(P.ws + WS_PART) + (size_t)(((((l * NB_S + b) * 4 + h) * 4) + rg) * 2 + comp) * PART_STRIDE;
#pragma unroll
            for (int c = 0; c < 4; ++c)
#pragma unroll
                for (int r = 0; r < 16; ++r) pb[(c * 16 + r) * 64 + lane] = O[c][r];
            pb[4096 + lane] = m_run; pb[4096 + 64 + lane] = l_tot; }
        __syncthreads();
    } else attn_finalize(lds, P, l, h, grow, comp, rg, lane, active, O, l_tot);
}

__device__ __forceinline__ void load8(const bf16* p, float (&v)[8]) { const v4u w = *(const v4u*)p; v[0] = bflo(w.x); v[1] = bfhi(w.x); v[2] = bflo(w.y); v[3] = bfhi(w.y); v[4] = bflo(w.z); v[5] = bfhi(w.z); v[6] = bflo(w.w); v[7] = bfhi(w.w); }
__device__ __forceinline__ void loadf8(const float* p, float (&v)[8]) { const f32x4 a = *(const f32x4*)p, b = *(const f32x4*)(p + 4); v[0] = a.x; v[1] = a.y; v[2] = a.z; v[3] = a.w; v[4] = b.x; v[5] = b.y; v[6] = b.z; v[7] = b.w; }
__device__ __forceinline__ void unpack8(const v4u w, float (&v)[8]) { v[0] = bflo(w.x); v[1] = bfhi(w.x); v[2] = bflo(w.y); v[3] = bfhi(w.y); v[4] = bflo(w.z); v[5] = bfhi(w.z); v[6] = bflo(w.w); v[7] = bfhi(w.w); }
template <int W>
__device__ __forceinline__ void pool_rows(const Params& P, int l, bool smp, int seq, int s0, int nrow, size_t rowbase, int ch, int rl) {
    const bf16* PROJ = (const bf16*)(P.ws + WS_HP); bf16* MIX = (bf16*)(P.ws + WS_MIX);
    const float* leftp = (const float*)(P.ws + WS_LEFTP) + (size_t)(l * NB_S + seq) * 15 * 256 + ch;
    const int sf = s0 + 4 * rl;
    (void)nrow;
    if (sf >= W - 1) {
        v4u raw[W], nx[3];
#pragma unroll
        for (int j = 0; j < W; ++j) raw[j] = *(const v4u*)(PROJ + (rowbase + sf - j) * LD_P_ + PC_UP + ch);
#pragma unroll
        for (int i = 1; i < 4; ++i) nx[i - 1] = *(const v4u*)(PROJ + (rowbase + sf + i) * LD_P_ + PC_UP + ch);
        float sum[8], cur[8];
#pragma unroll
        for (int e = 0; e < 8; ++e) sum[e] = 0.f;
#pragma unroll
        for (int j = 0; j < W; ++j) { float v[8]; unpack8(raw[j], v);
#pragma unroll
            for (int e = 0; e < 8; ++e) sum[e] += v[e]; }
        const float rc = 1.0f / (float)W;
#pragma unroll
        for (int i = 0; i < 4; ++i) {
            if (i > 0) { float vin[8], vout[8]; unpack8(nx[i - 1], vin); unpack8((W - i >= 0) ? raw[(W - i >= 0) ? W - i : 0] : nx[(i - W - 1 >= 0) ? i - W - 1 : 0], vout);
#pragma unroll
                for (int e = 0; e < 8; ++e) sum[e] += vin[e] - vout[e]; }
            unpack8(i == 0 ? raw[0] : nx[i > 0 ? i - 1 : 0], cur);
            v4u o; o.x = pk2f(sum[0] * rc - cur[0], sum[1] * rc - cur[1]); o.y = pk2f(sum[2] * rc - cur[2], sum[3] * rc - cur[3]);
            o.z = pk2f(sum[4] * rc - cur[4], sum[5] * rc - cur[5]); o.w = pk2f(sum[6] * rc - cur[6], sum[7] * rc - cur[7]);
            *(v4u*)(MIX + (rowbase + sf + i) * DM + ch) = o; }
    } else {
        for (int i = 0; i < 4; ++i) { const int s = sf + i;
            float acc[8], cur[8];
#pragma unroll
            for (int e = 0; e < 8; ++e) { acc[e] = 0.f; cur[e] = 0.f; }
#pragma unroll
            for (int j = 0; j < W; ++j) { const int sj = s - j; float v[8];
                if (sj >= 0) load8(PROJ + (rowbase + sj) * LD_P_ + PC_UP + ch, v);
                else if (smp) loadf8(leftp + (size_t)(15 + sj) * 256, v);
                else {
#pragma unroll
                    for (int e = 0; e < 8; ++e) v[e] = 0.f; }
#pragma unroll
                for (int e = 0; e < 8; ++e) { acc[e] += v[e]; if (j == 0) cur[e] = v[e]; } }
            const int pos = smp ? PAST + s : s; const float rc = 1.0f / (float)(pos + 1 < W ? pos + 1 : W);
            v4u o; o.x = pk2f(acc[0] * rc - cur[0], acc[1] * rc - cur[1]); o.y = pk2f(acc[2] * rc - cur[2], acc[3] * rc - cur[3]);
            o.z = pk2f(acc[4] * rc - cur[4], acc[5] * rc - cur[5]); o.w = pk2f(acc[6] * rc - cur[6], acc[7] * rc - cur[7]);
            *(v4u*)(MIX + (rowbase + s) * DM + ch) = o; }
    }
}
__device__ __forceinline__ void ew_item(const Params& P, int l, int item) {
    const int tid = tid_opaque(), lane = tid & 63, wv = __builtin_amdgcn_readfirstlane(tid >> 6), rl = lane >> 3;
    const bool smp = item >= 1024; const int seq = smp ? item - 1024 : item >> 7, rb = smp ? 0 : item & 127;
    const int S = smp ? DSEQ : SEQ, nrow = 32, s0 = rb * 32;
    const size_t rowbase = smp ? (size_t)(MP + seq * DSEQ) : (size_t)seq * SEQ;
    const bf16* PROJ = (const bf16*)(P.ws + WS_HP); bf16* MIX = (bf16*)(P.ws + WS_MIX);
    if (wv < 4) {
        const int ch = wv * 64 + (lane & 7) * 8;
        if (wv == 0) pool_rows<2>(P, l, smp, seq, s0, nrow, rowbase, ch, rl);
        else if (wv == 1) pool_rows<4>(P, l, smp, seq, s0, nrow, rowbase, ch, rl);
        else if (wv == 2) pool_rows<8>(P, l, smp, seq, s0, nrow, rowbase, ch, rl);
        else pool_rows<16>(P, l, smp, seq, s0, nrow, rowbase, ch, rl);
        if (s0 + nrow == S) {
            float* dst = P.out + (smp ? O_PLS + (size_t)(l * NB_S + seq) * 15 * 256 : O_PLP + (size_t)(l * NB_P + seq) * 15 * 256) + ch;
            for (int j = rl; j < 15; j += 8) { float v[8]; load8(PROJ + (rowbase + S - 15 + j) * LD_P_ + PC_U + ch, v);
                *(f32x4*)(dst + (size_t)j * 256) = (f32x4){v[0], v[1], v[2], v[3]}; *(f32x4*)(dst + (size_t)j * 256 + 4) = (f32x4){v[4], v[5], v[6], v[7]}; } }
    } else {
        const int ch = (wv - 4) * 64 + (lane & 7) * 8;
        const float* cw = P.in[14] + (size_t)l * 3 * 256 + ch; float w0[8], w1[8], w2[8]; loadf8(cw, w0); loadf8(cw + 256, w1); loadf8(cw + 512, w2);
        const float* leftc = P.in[5] + (size_t)(l * NB_S + seq) * 2 * 256 + ch;
        for (int i = 0; i * 8 < nrow; ++i) { const int s = s0 + rl + 8 * i;
            float z[3][8];
#pragma unroll
            for (int j = 0; j < 3; ++j) { const int sj = s - 2 + j;
                if (sj >= 0) { float c[8], hh[8]; load8(PROJ + (rowbase + sj) * LD_P_ + PC_C + ch, c); load8(PROJ + (rowbase + sj) * LD_P_ + PC_H + ch, hh);
#pragma unroll
                    for (int e = 0; e < 8; ++e) z[j][e] = c[e] * hh[e]; }
                else if (smp) loadf8(leftc + (size_t)(2 + sj) * 256, z[j]);
                else {
#pragma unroll
                    for (int e = 0; e < 8; ++e) z[j][e] = 0.f; } }
            float bg[8]; load8(PROJ + (rowbase + s) * LD_P_ + PC_B + ch, bg);
            float y[8];
#pragma unroll
            for (int e = 0; e < 8; ++e) y[e] = bg[e] * (w0[e] * z[0][e] + w1[e] * z[1][e] + w2[e] * z[2][e]);
            v4u o; o.x = pk2f(y[0], y[1]); o.y = pk2f(y[2], y[3]); o.z = pk2f(y[4], y[5]); o.w = pk2f(y[6], y[7]);
            *(v4u*)(MIX + (rowbase + s) * DM + 256 + ch) = o;
            if (s >= S - 2) { float* dst = P.out + (smp ? O_CVS + (size_t)(l * NB_S + seq) * 2 * 256 : O_CVP + (size_t)(l * NB_P + seq) * 2 * 256) + (size_t)(s - (S - 2)) * 256 + ch;
                *(f32x4*)dst = (f32x4){z[2][0], z[2][1], z[2][2], z[2][3]}; *(f32x4*)(dst + 4) = (f32x4){z[2][4], z[2][5], z[2][6], z[2][7]}; } }
    }
}
typedef const __attribute__((address_space(4))) Params* kparams_t;
__device__ __forceinline__ Params load_params() {
#if defined(__HIP_DEVICE_COMPILE__)
    kparams_t p = (kparams_t)__builtin_amdgcn_kernarg_segment_ptr(); asm volatile("" : "+s"(p)); return *p;
#else
    return Params{};
#endif
}
constexpr int NSMP = 8;
__device__ __forceinline__ void sample_subbar(unsigned* ctr, unsigned target) {
    __threadfence();
    __syncthreads();
    if (threadIdx.x == 0) { __hip_atomic_fetch_add(ctr, 1u, __ATOMIC_RELAXED, __HIP_MEMORY_SCOPE_AGENT);
        while (__hip_atomic_load(ctr, __ATOMIC_RELAXED, __HIP_MEMORY_SCOPE_AGENT) < target) __builtin_amdgcn_s_sleep(2); }
    __syncthreads();
    __threadfence();
}
__global__ void __launch_bounds__(NTHR, 2) fwd_megakernel(Params Pk_unused) {
    extern __shared__ __attribute__((aligned(16))) unsigned char lds_raw[];
    LAS unsigned char* lds = (LAS unsigned char*)lds_raw;
    cg::grid_group grid = cg::this_grid();
    const int G = gridDim.x, tid = threadIdx.x;
    if (tid < 8) ((LAS unsigned*)(lds + L_XB))[tid] = 0u;
    __syncthreads();
    XcdBarrier xbar;
    xbar.bar = nullptr; xbar.x = 0; xbar.st = nullptr;
    int lo, hi; { const Params P = load_params(); lo = P.ph_lo; hi = P.ph_hi; }
#define IN(k) (lo <= (k) && (k) < hi)
#if defined(USE_CG_SYNC)
#define SEAM(k) do { if (IN(k) && IN((k) + 1)) grid.sync(); } while (0)
#else
#define SEAM(k) do { if (IN(k) && IN((k) + 1)) xcd_barrier(xbar); } while (0)
#endif
    if (IN(0)) {
#ifndef NO_PRO
        const Params P = load_params(); prologue(P, lds, G);
#ifdef PROBE_PRO2
        __syncthreads(); prologue(P, lds, G);
#endif
#endif
    }
    if (IN(0) && blockIdx.x == 0) { const Params P = load_params(); unsigned* bw_ = (unsigned*)(P.ws + WS_XBAR); for (int i = tid; i < 4096; i += NTHR) bw_[i] = 0u; }
    if (IN(0) && IN(1)) grid.sync();
    { const Params P0 = load_params(); xbar = xcd_barrier_post((unsigned*)(P0.ws + WS_XBAR), (volatile LAS unsigned*)(lds + L_XB)); }
    const bool smpCU = (int)blockIdx.x < NSMP;
    const int pbid = (int)blockIdx.x - NSMP, PG = G - NSMP;
    unsigned sgen = 0;
#define LNP(P_, idx_, ro_) ((idx_) < 0 ? nullptr : (const float*)((P_).ws + WS_STATS) + 2 * (size_t)(ro_)), ((idx_) < 0 ? nullptr : (P_).in[6] + (size_t)(idx_) * DM), ((idx_) < 0 ? nullptr : (P_).in[7] + (size_t)(idx_) * DM)
#define SUBBAR() do { const Params Pq = load_params(); ++sgen; sample_subbar((unsigned*)(Pq.ws + WS_CTL) + 200, sgen * (unsigned)NSMP); } while (0)
#define SPTR(P_, li_, ro_) ((float*)((P_).ws + WS_STATS) + (size_t)((li_) & 1) * MT * 8 + (size_t)(ro_) * 8)
#define LNG(P_, li_) ((P_).in[6] + (size_t)(li_) * DM)
#define LNB(P_, li_) ((P_).in[7] + (size_t)(li_) * DM)
#define CGP(P_, c_) ((const float*)((P_).ws + WS_CGBW) + (size_t)(c_) * 2 * NUP)
#define TABP ((LAS float*)(lds + L_TAB))
#define FOLDP ((LAS float*)(lds + L_FOLD))
#pragma nounroll
    for (int l = 0; l < NLAYER; ++l) {
        const int pb = 1 + 8 * l;
#pragma nounroll
        for (int f = 0; f < 2; ++f) {
            const int p_up = pb + (f ? 6 : 0), p_dn = p_up + 1;
            const int li_in = f ? l * 3 + 1 : l * 3 - 1;
            const int li_out = f ? l * 3 + 2 : l * 3;
            if (IN(p_up)) {
                const int mi = l * 2 + f;
                if (smpCU && f == 1) {
                    { const Params P = load_params(); unsigned char* ws = P.ws;
                      pg8::Gemm g{(const pg8::bf16_t*)(ws + WS_MIX) + (size_t)MP * DM, (const pg8::bf16_t*)(ws + WS_WOUT) + (size_t)l * SZ_WOUT, MS, DM, DM};
                      pg8::FoldOrder S; S.init(MS, DM, NSMP, (int)blockIdx.x); S.sp = SPTR(P, l * 3, MP); S.cg = LNG(P, l * 3); S.bw = LNB(P, l * 3); S.tabs = FOLDP; S.ncall = 0;
                      pg8::EpiRes E{nullptr, nullptr, ALPHA, 1.0f, 1, (pg8::ldsf_t)FOLDP, &S,
                                    SPTR(P, l * 3 + 1, MP), LNG(P, l * 3 + 1), (pg8::bf16_t*)(ws + WS_XB) + (size_t)MP * DM, TABP, 0};
                      pg8::gemm_phase<pg8::EpiRes, pg8::FoldOrder, true, true>(lds, g, S, E); }
                    SUBBAR();
                }
                {
                    const Params P = load_params(); unsigned char* ws = P.ws;
                    const size_t ro = smpCU ? (size_t)MP : 0; const int c = l * 3 + (f ? 2 : 0);
                    pg8::Gemm g{(const pg8::bf16_t*)(ws + WS_XB) + ro * DM, (const pg8::bf16_t*)(ws + WS_WUP) + (size_t)mi * SZ_WUP, smpCU ? MS : MP, NUP, DM};
                    pg8::FoldOrder S; S.init(smpCU ? MS : MP, NUP, smpCU ? NSMP : PG, smpCU ? (int)blockIdx.x : pbid);
                    S.sp = li_in < 0 ? nullptr : (const float*)SPTR(P, li_in, ro); S.cg = CGP(P, c); S.bw = CGP(P, c) + NUP; S.tabs = FOLDP; S.ncall = 0;
                    pg8::EpiGlu E{(pg8::bf16_t*)(ws + WS_HP) + ro * DFF, li_in < 0 ? 0 : 1, (pg8::ldsf_t)FOLDP, &S, 0};
#ifdef PROBE_UP2
                    for (int rep_ = 0; rep_ < 2; ++rep_) { S.ncall = 0; E.nepi = 0; __syncthreads();
#endif
                    pg8::gemm_phase<pg8::EpiGlu, pg8::FoldOrder, true, true>(lds, g, S, E);
#ifdef PROBE_UP2
                    }
#endif
                }
                if (smpCU) {
                    SUBBAR();
                    const Params P = load_params(); unsigned char* ws = P.ws;
                    pg8::Gemm g{(const pg8::bf16_t*)(ws + WS_HP) + (size_t)MP * DFF, (const pg8::bf16_t*)(ws + WS_WDN) + (size_t)mi * SZ_WDN, MS, DM, DFF};
                    pg8::FoldOrder S; S.init(MS, DM, NSMP, (int)blockIdx.x); S.sp = li_in < 0 ? nullptr : (const float*)SPTR(P, li_in, MP); S.cg = li_in < 0 ? nullptr : LNG(P, li_in); S.bw = li_in < 0 ? nullptr : LNB(P, li_in); S.tabs = FOLDP; S.ncall = 0;
                    pg8::EpiRes E{P.in[1], nullptr, ALPHA, 0.5f, li_in < 0 ? 0 : 1, (pg8::ldsf_t)FOLDP, &S,
                                  SPTR(P, li_out, MP), LNG(P, li_out), (pg8::bf16_t*)(ws + WS_XB) + (size_t)MP * DM, TABP, 0};
                    pg8::gemm_phase<pg8::EpiRes, pg8::FoldOrder, true, true>(lds, g, S, E);
                }
            }
            SEAM(p_up);
            if (IN(p_dn)) {
                const int mi = l * 2 + f; const Params P = load_params(); unsigned char* ws = P.ws;
                pg8::Gemm g{(const pg8::bf16_t*)(ws + WS_HP), (const pg8::bf16_t*)(ws + WS_WDN) + (size_t)mi * SZ_WDN, MP, DM, DFF};
                pg8::FoldOrder S; S.init(MP, DM, G, (int)blockIdx.x); S.sp = li_in < 0 ? nullptr : (const float*)SPTR(P, li_in, 0); S.cg = li_in < 0 ? nullptr : LNG(P, li_in); S.bw = li_in < 0 ? nullptr : LNB(P, li_in); S.tabs = FOLDP; S.ncall = 0;
                pg8::EpiRes E{P.in[0], nullptr, ALPHA, 0.5f, li_in < 0 ? 0 : 1, (pg8::ldsf_t)FOLDP, &S,
                              SPTR(P, li_out, 0), LNG(P, li_out), (pg8::bf16_t*)(ws + WS_XB), TABP, 0};
                pg8::gemm_phase<pg8::EpiRes, pg8::FoldOrder, true, true>(lds, g, S, E);
            }
            SEAM(p_dn);
            if (f) break;
            if (IN(pb + 2)) { const Params P = load_params(); unsigned char* ws = P.ws;
                const size_t ro = smpCU ? (size_t)MP : 0; const int c = l * 3 + 1;
                pg8::Gemm g{(const pg8::bf16_t*)(ws + WS_XB) + ro * DM, (const pg8::bf16_t*)(ws + WS_WIN) + (size_t)l * SZ_WIN, smpCU ? MS : MP, NPROJ, DM};
                pg8::FoldOrder S; S.init(smpCU ? MS : MP, NPROJ, smpCU ? NSMP : PG, smpCU ? (int)blockIdx.x : pbid);
                S.sp = (const float*)SPTR(P, l * 3, ro); S.cg = CGP(P, c); S.bw = CGP(P, c) + NUP; S.tabs = FOLDP; S.ncall = 0;
                pg8::EpiProj E{(pg8::bf16_t*)(ws + WS_HP) + ro * NPROJ, QSCALE, P.out, l, smpCU ? 1 : 0, (pg8::ldsf_t)FOLDP, &S, 0};
                pg8::gemm_phase<pg8::EpiProj, pg8::FoldOrder, true, true>(lds, g, S, E);
            }
            SEAM(pb + 2);
            if (IN(pb + 3)) { const Params P = load_params(); unsigned char* ws = P.ws;
                unsigned* ctr = (unsigned*)(ws + WS_CTL) + 64 * l;
                volatile LAS unsigned* qw = (volatile LAS unsigned*)(lds + L_Q);
                constexpr int NU = 64 + 1024 + 1024 + 16;
                for (;;) {
                    if (tid == 0) qw[0] = atomicAdd(ctr, 1u);
                    __syncthreads();
                    const int u = (int)qw[0];
                    __syncthreads();
                    if (u >= NU) break;
                    if (u >= 256 && u < 320) { const int v = u - 256; attn_unit<true>(lds, P, l, v >> 2, v & 3, 0); }
                    else if (u < 64 + 1024) { const int i = u < 256 ? u : u - 64; attn_unit<false>(lds, P, l, (i & 31) >> 2, i & 3, 31 - (i >> 5)); }
                    else ew_item(P, l, u - 1088);
                }
            }
            SEAM(pb + 3);
            if (IN(pb + 4)) { const Params P = load_params();
                for (int it = blockIdx.x; it < 64; it += G) attn_combine(lds, P, l, it >> 2, it & 3);
            }
            SEAM(pb + 4);
            if (IN(pb + 5)) { const Params P = load_params(); unsigned char* ws = P.ws;
                pg8::Gemm g{(const pg8::bf16_t*)(ws + WS_MIX), (const pg8::bf16_t*)(ws + WS_WOUT) + (size_t)l * SZ_WOUT, MP, DM, DM};
                pg8::FoldOrder S; S.init(MP, DM, G, (int)blockIdx.x); S.sp = SPTR(P, l * 3, 0); S.cg = LNG(P, l * 3); S.bw = LNB(P, l * 3); S.tabs = FOLDP; S.ncall = 0;
                pg8::EpiRes E{nullptr, nullptr, ALPHA, 1.0f, 1, (pg8::ldsf_t)FOLDP, &S,
                              SPTR(P, l * 3 + 1, 0), LNG(P, l * 3 + 1), (pg8::bf16_t*)(ws + WS_XB), TABP, 0};
                pg8::gemm_phase<pg8::EpiRes, pg8::FoldOrder, true, true>(lds, g, S, E);
            }
            SEAM(pb + 5);
        }
    }
    if (IN(NPHASE - 1)) {
        const Params P = load_params(); constexpr int lj = (NLAYER - 1) * 3 + 2;
        final_ln(P, G, (const float*)(P.ws + WS_STATS) + (size_t)(lj & 1) * MT * 8, P.in[6] + (size_t)lj * DM, P.in[7] + (size_t)lj * DM, P.out + O_Y);
    }
#undef SPTR
#undef LNG
#undef LNB
#undef CGP
#undef TABP
#undef FOLDP
#undef IN
#undef SUBBAR
#undef LNP
#undef SEAM
}

#ifndef MK_N_LAUNCHES
#define MK_N_LAUNCHES 1
#endif
extern "C" void kernel_launch(void* const* d_in, const int* in_sizes, int n_in, void* d_out, int out_size, void* d_ws, size_t ws_size, hipStream_t stream) {
    static int grid = 0;
    if (grid == 0) {
        if (n_in != 18 || (size_t)out_size != O_END || ws_size < WS_END) { fprintf(stderr, "kernel_launch: unexpected shapes: n_in %d out_size %d ws_size %zu\n", n_in, out_size, ws_size); grid = -1; return; }
        int dev = 0, cus = 0, per_cu = 0;
        if (hipGetDevice(&dev) != hipSuccess || hipDeviceGetAttribute(&cus, hipDeviceAttributeMultiprocessorCount, dev) != hipSuccess) { grid = -1; return; }
        if (hipFuncSetAttribute((const void*)fwd_megakernel, hipFuncAttributeMaxDynamicSharedMemorySize, LDS_BYTES) != hipSuccess) { fprintf(stderr, "kernel_launch: hipFuncSetAttribute failed\n"); grid = -1; return; }
        if (hipOccupancyMaxActiveBlocksPerMultiprocessor(&per_cu, (const void*)fwd_megakernel, NTHR, LDS_BYTES) != hipSuccess || per_cu < 1) { fprintf(stderr, "kernel_launch: occupancy query gave %d\n", per_cu); per_cu = 1; }
        (void)hipGetLastError();
        grid = cus * per_cu;
        fprintf(stderr, "kernel_launch: grid %d (cus %d x %d)\n", grid, cus, per_cu);
    }
    if (grid < 0) return;
    Params p{};
    for (int i = 0; i < 18; ++i) p.in[i] = (const float*)d_in[i];
    p.out = (float*)d_out; p.ws = (unsigned char*)d_ws;
    const int nl = MK_N_LAUNCHES;
    for (int li = 0; li < nl; ++li) {
        p.ph_lo = (int)((long)NPHASE * li / nl); p.ph_hi = (int)((long)NPHASE * (li + 1) / nl);
        void* args[] = {&p};
        hipError_t e = hipLaunchCooperativeKernel((const void*)fwd_megakernel, dim3(grid), dim3(NTHR), args, LDS_BYTES, stream);
        if (e != hipSuccess) { fprintf(stderr, "kernel_launch: cooperative launch %d failed: %s (grid %d)\n", li, hipGetErrorString(e), grid); break; }
    }
}
```

```cpp
#include <hip/hip_runtime.h>
#include <hip/hip_cooperative_groups.h>
#include <hip/hip_bf16.h>
#include <cstdio>
#include <cstdint>
namespace cg = cooperative_groups;
__device__ __forceinline__ int tid_opaque() { int t = threadIdx.x; asm volatile("" : "+v"(t)); return t; }
namespace pg8 {
#define PG8_LAS __attribute__((address_space(3)))
typedef unsigned short bf16_t;
typedef short bf16x8 __attribute__((ext_vector_type(8)));
typedef float f32x4 __attribute__((ext_vector_type(4)));
typedef unsigned u32x4 __attribute__((ext_vector_type(4)));
constexpr int BM = 256, BK = 64, HALF = 128, HTB = HALF * BK * 2  , STAGE_BYTES = 8 * HTB, NXCD = 8, WGM = 8;

__host__ __device__ __forceinline__ int lds_byte(int r, int c) { const int st = (r >> 4) * 2 + (c >> 5), rr = r & 15, cc = c & 31, ob = rr * 64 + cc * 2; return st * 1024 + (ob ^ (((ob >> 9) & 1) << 5)); }
__host__ __device__ __forceinline__ void stage_rc(int b, int& R, int& C) { const int st = b / 1024, sb = b % 1024, swz = sb ^ (((sb >> 9) & 1) << 5); R = (st >> 1) * 16 + swz / 64; C = (st & 1) * 32 + (swz % 64) / 2; }
__host__ __device__ __forceinline__ int perm32(int rho) { const int n = rho >> 4, i = rho & 15; return 8 * (i >> 2) + 4 * n + (i & 3); }

struct Unit { int pm, pn; };
struct Gemm { const bf16_t* A; const bf16_t* Bt; int M, N, K; };

struct StaticOrder {
    int nM, nN, nwg, G, c;
    __host__ __device__ void init(int M, int N, int G_, int c_) { nM = M / BM; nN = N / BM; nwg = nM * nN; G = G_; c = c_; }
    __host__ __device__ bool next(int i, Unit& u) const {
        const long L = (long)i * G + c; if (L >= nwg) return false;
        int wgid = (int)L; { const int q = nwg / NXCD, r = nwg % NXCD, xcd = wgid % NXCD, off = wgid / NXCD; wgid = (xcd < r ? xcd * (q + 1) : r * (q + 1) + (xcd - r) * q) + off; }
        const int nig = WGM * nN, gid = wgid / nig, fm = gid * WGM, gsz = (nM - fm) < WGM ? (nM - fm) : WGM;
        u.pm = fm + ((wgid % nig) % gsz); u.pn = (wgid % nig) / gsz; return true;
    }
    __device__ __forceinline__ void a_ready(const Unit&) const {}
    __device__ __forceinline__ void done(const Unit&) const {}
};

typedef __bf16 bf16x2_t __attribute__((ext_vector_type(2)));
typedef float f32x2_t __attribute__((ext_vector_type(2)));
__device__ __forceinline__ unsigned pk_bf16(float lo, float hi) { f32x2_t v = {lo, hi}; bf16x2_t b = __builtin_convertvector(v, bf16x2_t); return __builtin_bit_cast(unsigned, b); }
__device__ __forceinline__ float silu_f(float g) { return g * __builtin_amdgcn_rcpf(1.0f + __builtin_amdgcn_exp2f(-1.4426950408889634f * g)); }
constexpr int LD_H = 2816, LD_P = 2816, LD_X = 1024;
constexpr float LNE = 1e-5f;
__device__ __forceinline__ void row_mean_rstd(const float* sp, int row, float& mean, float& rstd) {
    const f32x4 a = *(const f32x4*)(sp + (size_t)row * 8), b = *(const f32x4*)(sp + (size_t)row * 8 + 4);
    const float s1 = (a[0] + a[2]) + (b[0] + b[2]), s2 = (a[1] + a[3]) + (b[1] + b[3]);
    mean = s1 * (1.0f / 1024.0f); const float var = s2 * (1.0f / 1024.0f) - mean * mean; rstd = 1.0f / __builtin_sqrtf(var + LNE);
}
struct FoldOrder : StaticOrder {
    const float* sp; const float* cg; const float* bw; __attribute__((address_space(3))) float* tabs; mutable int ncall;
    __device__ __forceinline__ void a_ready(const Unit& u) const {
        if (ncall != 0 || sp == nullptr) { ++ncall; return; }
        ++ncall;
        const int t = tid_opaque();
        if (t < 256) { float mu, rs; row_mean_rstd(sp, u.pm * BM + t, mu, rs); tabs[2 * t] = mu; tabs[2 * t + 1] = rs; }
        else { const int j = t - 256; tabs[512 + j] = cg[u.pn * BM + j]; tabs[768 + j] = bw[u.pn * BM + j]; }
    }
    __device__ __forceinline__ bool fold_prefetch(int i, f32x4& ra, f32x4& rb) const {
        Unit nx; if (sp == nullptr || !next(i, nx)) return false;
        const int t = tid_opaque();
        if (t < 256) { const float* q = sp + (size_t)(nx.pm * BM + t) * 8; ra = *(const f32x4*)q; rb = *(const f32x4*)(q + 4); }
        else { const int j = t - 256; ra[0] = cg[nx.pn * BM + j]; ra[1] = bw[nx.pn * BM + j]; }
        return true;
    }
    __device__ __forceinline__ void fold_commit(int i, const f32x4& a, const f32x4& b) const {
        __attribute__((address_space(3))) float* T = tabs + (i & 1) * 1024; const int t = tid_opaque();
        if (t < 256) { const float s1 = (a[0] + a[2]) + (b[0] + b[2]), s2 = (a[1] + a[3]) + (b[1] + b[3]);
            const float mean = s1 * (1.0f / 1024.0f), var = s2 * (1.0f / 1024.0f) - mean * mean; T[2 * t] = mean; T[2 * t + 1] = 1.0f / __builtin_sqrtf(var + LNE); }
        else { const int j = t - 256; T[512 + j] = a[0]; T[768 + j] = a[1]; }
    }
};
typedef __attribute__((address_space(3))) const float* ldsf_t;
struct EpiGlu {
    static constexpr bool PERM = true, AFTER_DRAIN = false;
    bf16_t* H; int ln; ldsf_t tabs; const FoldOrder* so; mutable int nepi;
    __device__ __forceinline__ void operator()(const f32x4 (&acc)[2][2][4][2], const Unit& u, int wr, int wc, int fr, int fq) const {
        const int row0 = u.pm * BM + wr * 64 + fr, col0 = u.pn * 128 + wc * 32 + 8 * fq, jc = wc * 32 + 8 * fq;
        ldsf_t T = tabs + (nepi & 1) * 1024;
        f32x4 ra = {0.f, 0.f, 0.f, 0.f}, rb = {0.f, 0.f, 0.f, 0.f}; const bool hn = so->fold_prefetch(nepi + 1, ra, rb);
        f32x4 cgv[4], bwv[4];
        if (ln) {
#pragma unroll
            for (int q = 0; q < 4; ++q) { const int j = jc + (q >> 1) * HALF + (q & 1) * 4; cgv[q] = *(const __attribute__((address_space(3))) f32x4*)(T + 512 + j); bwv[q] = *(const __attribute__((address_space(3))) f32x4*)(T + 768 + j); } }
#pragma unroll
        for (int ai = 0; ai < 2; ++ai)
#pragma unroll
            for (int m = 0; m < 4; ++m) {
                const int rl = wr * 64 + fr + ai * HALF + m * 16;
                bf16_t* rowp = H + (size_t)(u.pm * BM + rl) * LD_H + col0;
                f32x4 g0 = acc[ai][0][m][0], g1 = acc[ai][0][m][1], u0 = acc[ai][1][m][0], u1 = acc[ai][1][m][1];
                if (ln) { const f32x2_t mr = *(const __attribute__((address_space(3))) f32x2_t*)(T + 2 * rl); const float mu = mr[0], rs = mr[1];
                    g0 = (g0 - mu * cgv[0]) * rs + bwv[0]; g1 = (g1 - mu * cgv[1]) * rs + bwv[1]; u0 = (u0 - mu * cgv[2]) * rs + bwv[2]; u1 = (u1 - mu * cgv[3]) * rs + bwv[3]; }
                u32x4 w;
                w.x = pk_bf16(silu_f(g0[0]) * u0[0], silu_f(g0[1]) * u0[1]); w.y = pk_bf16(silu_f(g0[2]) * u0[2], silu_f(g0[3]) * u0[3]);
                w.z = pk_bf16(silu_f(g1[0]) * u1[0], silu_f(g1[1]) * u1[1]); w.w = pk_bf16(silu_f(g1[2]) * u1[2], silu_f(g1[3]) * u1[3]);
                *(u32x4*)rowp = w;
            }
        (void)row0;
        if (hn) so->fold_commit(nepi + 1, ra, rb);
        ++nepi;
    }
};
struct EpiRes {
    static constexpr bool PERM = true, AFTER_DRAIN = false;
    const float* Xin; float* X; float alpha, s;
    int ln; ldsf_t ftab; const FoldOrder* so;
    float* spo; const float* gn; bf16_t* XB;
    __attribute__((address_space(3))) float* tab;
    mutable int nepi;
    __device__ __forceinline__ void operator()(const f32x4 (&acc)[2][2][4][2], const Unit& u, int wr, int wc, int fr, int fq) const {
        const int rl0 = wr * 64 + fr, col0 = u.pn * BM + wc * 32 + 8 * fq, jc = wc * 32 + 8 * fq;
        ldsf_t T = ftab + (nepi & 1) * 1024;
        f32x4 ra = {0.f, 0.f, 0.f, 0.f}, rb = {0.f, 0.f, 0.f, 0.f}; const bool hn = so->fold_prefetch(nepi + 1, ra, rb);
        f32x4 gnv[2][2];
#pragma unroll
        for (int bj = 0; bj < 2; ++bj)
#pragma unroll
            for (int n = 0; n < 2; ++n) gnv[bj][n] = *(const f32x4*)(gn + col0 + bj * HALF + n * 4);
#pragma unroll
        for (int aih = 0; aih < 4; ++aih) { const int ai = aih >> 1, mh = (aih & 1) * 2;
            f32x4 xa[4][2][2];
#pragma unroll
            for (int m = mh; m < mh + 2; ++m) { const size_t ro_ = (size_t)(u.pm * BM + rl0 + ai * HALF + m * 16) * LD_X + col0;
                if (ln) {
#pragma unroll
                    for (int bj = 0; bj < 2; ++bj) { const u32x4 w = *(const u32x4*)(XB + ro_ + bj * HALF);
                        xa[m][bj][0] = (f32x4){__builtin_bit_cast(float, w.x << 16), __builtin_bit_cast(float, w.x & 0xffff0000u), __builtin_bit_cast(float, w.y << 16), __builtin_bit_cast(float, w.y & 0xffff0000u)};
                        xa[m][bj][1] = (f32x4){__builtin_bit_cast(float, w.z << 16), __builtin_bit_cast(float, w.z & 0xffff0000u), __builtin_bit_cast(float, w.w << 16), __builtin_bit_cast(float, w.w & 0xffff0000u)}; }
                } else {
#pragma unroll
                    for (int bj = 0; bj < 2; ++bj)
#pragma unroll
                        for (int n = 0; n < 2; ++n) xa[m][bj][n] = *(const f32x4*)(Xin + ro_ + bj * HALF + n * 4); } }
#pragma unroll
            for (int m = mh; m < mh + 2; ++m) {
                const int rl = rl0 + ai * HALF + m * 16, row = u.pm * BM + rl;
                const size_t ro_ = (size_t)row * LD_X + col0; bf16_t* bp_ = XB + ro_;
                f32x4 xv[2][2];
#pragma unroll
                for (int bj = 0; bj < 2; ++bj)
#pragma unroll
                    for (int n = 0; n < 2; ++n) xv[bj][n] = xa[m][bj][n];
                if (ln) { const f32x2_t mr = *(const __attribute__((address_space(3))) f32x2_t*)(T + 2 * rl); const float mu = mr[0], rs = mr[1];
#pragma unroll
                    for (int bj = 0; bj < 2; ++bj)
#pragma unroll
                        for (int n = 0; n < 2; ++n) { const int j = jc + bj * HALF + n * 4;
                            const f32x4 gg = *(const __attribute__((address_space(3))) f32x4*)(T + 512 + j), bb = *(const __attribute__((address_space(3))) f32x4*)(T + 768 + j);
                            xv[bj][n] = (xv[bj][n] - mu * gg) * rs + bb; } }
                float s1 = 0.f, s2 = 0.f;
#pragma unroll
                for (int bj = 0; bj < 2; ++bj) {
                    const f32x4 y0 = xv[bj][0] * alpha + acc[ai][bj][m][0] * s, y1 = xv[bj][1] * alpha + acc[ai][bj][m][1] * s;
                    if (X) { float* rp = X + ro_; *(f32x4*)(rp + bj * HALF) = y0; *(f32x4*)(rp + bj * HALF + 4) = y1; }
                    const f32x4 g0 = y0 * gnv[bj][0], g1 = y1 * gnv[bj][1];
                    u32x4 w; w.x = pk_bf16(g0[0], g0[1]); w.y = pk_bf16(g0[2], g0[3]); w.z = pk_bf16(g1[0], g1[1]); w.w = pk_bf16(g1[2], g1[3]);
                    *(u32x4*)(bp_ + bj * HALF) = w;
                    s1 += ((y0[0] + y0[1]) + (y0[2] + y0[3])) + ((y1[0] + y1[1]) + (y1[2] + y1[3]));
                    s2 += ((y0[0] * y0[0] + y0[1] * y0[1]) + (y0[2] * y0[2] + y0[3] * y0[3])) + ((y1[0] * y1[0] + y1[1] * y1[1]) + (y1[2] * y1[2] + y1[3] * y1[3])); }
                s1 += __shfl_xor(s1, 16); s1 += __shfl_xor(s1, 32); s2 += __shfl_xor(s2, 16); s2 += __shfl_xor(s2, 32);
                if (fq == 0) { tab[(rl * 4 + wc) * 2] = s1; tab[(rl * 4 + wc) * 2 + 1] = s2; }
            }
        }
        if (hn) so->fold_commit(nepi + 1, ra, rb);
        ++nepi;
        asm volatile("s_waitcnt lgkmcnt(0)" ::: "memory"); __builtin_amdgcn_s_barrier(); asm volatile("" ::: "memory");
        const int t = tid_opaque();
        if (t < 256) { const __attribute__((address_space(3))) float* q = tab + t * 8;
            const float a = (q[0] + q[2]) + (q[4] + q[6]), b = (q[1] + q[3]) + (q[5] + q[7]);
            f32x2_t o = {a, b}; *(f32x2_t*)(spo + ((size_t)(u.pm * BM + t) * 4 + u.pn) * 2) = o; }
    }
};
struct EpiProj {
    static constexpr bool PERM = true, AFTER_DRAIN = false;
    bf16_t* P; float qscale; float* out; int l; int smp_;
    ldsf_t tabs; const FoldOrder* so; mutable int nepi;
    __device__ __forceinline__ void operator()(const f32x4 (&acc)[2][2][4][2], const Unit& u, int wr, int wc, int fr, int fq) const {
        const int pn = u.pn, col0 = pn * BM + wc * 32 + 8 * fq, jc = wc * 32 + 8 * fq;
        ldsf_t T = tabs + (nepi & 1) * 1024;
        f32x4 ra = {0.f, 0.f, 0.f, 0.f}, rb = {0.f, 0.f, 0.f, 0.f}; const bool hn = so->fold_prefetch(nepi + 1, ra, rb);
        const float sc = (pn == 5 || pn == 6) ? qscale : 1.0f;
        const bool has_side = pn >= 7, isk = pn < 9, smp = smp_ != 0;
        const size_t sbase = smp ? ((isk ? (size_t)101257216 : (size_t)101781504) + (size_t)l * 512 * 512) : ((isk ? (size_t)34078720 : (size_t)67633152) + (size_t)l * 32768 * 512);
        const int scol = (pn - (isk ? 7 : 9)) * BM + wc * 32 + 8 * fq;
        f32x4 cgv[4], bwv[4];
#pragma unroll
        for (int q = 0; q < 4; ++q) { const int j = jc + (q >> 1) * HALF + (q & 1) * 4; cgv[q] = *(const __attribute__((address_space(3))) f32x4*)(T + 512 + j); bwv[q] = *(const __attribute__((address_space(3))) f32x4*)(T + 768 + j); }
#pragma unroll
        for (int ai = 0; ai < 2; ++ai)
#pragma unroll
            for (int m = 0; m < 4; ++m) {
                const int rl = wr * 64 + fr + ai * HALF + m * 16, row = u.pm * BM + rl;
                bf16_t* rowp = P + (size_t)row * LD_P + col0;
                const f32x2_t mr = *(const __attribute__((address_space(3))) f32x2_t*)(T + 2 * rl); const float mu = mr[0], rs = mr[1];
#pragma unroll
                for (int bj = 0; bj < 2; ++bj) {
                    const f32x4 v0 = ((acc[ai][bj][m][0] - mu * cgv[2 * bj]) * rs + bwv[2 * bj]) * sc, v1 = ((acc[ai][bj][m][1] - mu * cgv[2 * bj + 1]) * rs + bwv[2 * bj + 1]) * sc;
                    u32x4 w; w.x = pk_bf16(v0[0], v0[1]); w.y = pk_bf16(v0[2], v0[3]); w.z = pk_bf16(v1[0], v1[1]); w.w = pk_bf16(v1[2], v1[3]);
                    *(u32x4*)(rowp + bj * HALF) = w;
                    if (has_side) { float* sp2 = out + sbase + (size_t)row * 512 + scol + bj * HALF; *(f32x4*)sp2 = v0; *(f32x4*)(sp2 + 4) = v1; }
                }
            }
        if (hn) so->fold_commit(nepi + 1, ra, rb);
        ++nepi;
    }
};
template <class Epi, class Sched, bool ALIGN_EPI = false, bool SP2 = false>
__device__ __forceinline__ void gemm_phase(PG8_LAS unsigned char* lds, const Gemm g, const Sched& S, const Epi& E) {
    const int tid = tid_opaque(), wid = __builtin_amdgcn_readfirstlane(tid >> 6), lane = tid & 63, wr = wid >> 2, wc = wid & 3, fr = lane & 15, fq = lane >> 4;
    const int K = g.K, nt = K / BK;
    unsigned voffA[2], voffB[2];
#pragma unroll
    for (int i = 0; i < 2; ++i) { int R, C; stage_rc(tid * 16 + i * 8192, R, C); const int Rb = Epi::PERM ? ((R & ~31) + perm32(R & 31)) : R;
        voffA[i] = (unsigned)(R * K + C) * 2u; voffB[i] = (unsigned)(Rb * K + C) * 2u; }
    const size_t kstep = (size_t)(BK * 2);
    const size_t hstep = (size_t)HALF * K * 2;
    const size_t tstep = 2 * hstep;
    const unsigned ldsw = (unsigned)wid * 1024u;
    const int aoff = lds_byte(wr * 64 + fr, fq * 8), boff = lds_byte(wc * 32 + fr, fq * 8);
#define PG8_SA(b, h) (((b) * 2 + (h)) * HTB)
#define PG8_SB(b, h) ((4 + (b) * 2 + (h)) * HTB)
#define PG8_STAGE(bufoff, gbase, voff) do { _Pragma("unroll") for (int _i = 0; _i < 2; ++_i) \
        __builtin_amdgcn_global_load_lds((const unsigned*)((const char*)(gbase) + (voff)[_i]), (PG8_LAS unsigned*)(lds + (bufoff) + ldsw + _i * 8192), 16, 0, 0); } while (0)
#define PG8_LDA(dst, b, h) do { _Pragma("unroll") for (int m = 0; m < 4; ++m) _Pragma("unroll") for (int k = 0; k < 2; ++k) dst[m][k] = *(const PG8_LAS bf16x8*)(lds + PG8_SA(b, h) + aoff + m * 2048 + k * 1024); } while (0)
#define PG8_LDB(dst, b, h) do { _Pragma("unroll") for (int n = 0; n < 2; ++n) _Pragma("unroll") for (int k = 0; k < 2; ++k) dst[n][k] = *(const PG8_LAS bf16x8*)(lds + PG8_SB(b, h) + boff + n * 2048 + k * 1024); } while (0)
#define PG8_MMA(ai, bj, At, Bt) do { __builtin_amdgcn_s_setprio(1); _Pragma("unroll") for (int m = 0; m < 4; ++m) _Pragma("unroll") for (int n = 0; n < 2; ++n) _Pragma("unroll") for (int k = 0; k < 2; ++k) \
        acc[ai][bj][m][n] = __builtin_amdgcn_mfma_f32_16x16x32_bf16(Bt[n][k], At[m][k], acc[ai][bj][m][n], 0, 0, 0); __builtin_amdgcn_s_setprio(0); } while (0)
#define PG8_WAIT_V(n) asm volatile("s_waitcnt vmcnt(" #n ")" ::: "memory")
#define PG8_WAIT_L(n) asm volatile("s_waitcnt lgkmcnt(" #n ")" ::: "memory")
#define PG8_BAR __builtin_amdgcn_s_barrier()
#define PG8_SCHED __builtin_amdgcn_sched_barrier(0)
    Unit cur, nxt; int ui = 0;
    if (!S.next(0, cur)) return;
    f32x4 acc[2][2][4][2];
#pragma unroll
    for (int a = 0; a < 2; ++a)
#pragma unroll
        for (int b = 0; b < 2; ++b)
#pragma unroll
            for (int m = 0; m < 4; ++m)
#pragma unroll
                for (int n = 0; n < 2; ++n) acc[a][b][m][n] = (f32x4){0.f, 0.f, 0.f, 0.f};
    bf16x8 At[4][2], B0[2][2], B1[2][2];
    const char* cA = (const char*)g.A + (size_t)cur.pm * tstep; const char* cB = (const char*)g.Bt + (size_t)cur.pn * tstep;
    S.a_ready(cur);
    if constexpr (SP2) {
        PG8_STAGE(PG8_SB(0, 0), cB, voffB); PG8_STAGE(PG8_SB(0, 1), cB + hstep, voffB); PG8_STAGE(PG8_SA(0, 0), cA, voffA); PG8_STAGE(PG8_SA(0, 1), cA + hstep, voffA);
        if (wr == 1) PG8_BAR;
        PG8_WAIT_V(2); PG8_BAR;
        PG8_STAGE(PG8_SB(1, 0), cB + kstep, voffB); PG8_STAGE(PG8_SA(1, 0), cA + kstep, voffA); PG8_STAGE(PG8_SB(1, 1), cB + hstep + kstep, voffB);
        PG8_WAIT_V(6); PG8_BAR;
    } else {
        PG8_STAGE(PG8_SB(0, 0), cB, voffB); PG8_STAGE(PG8_SA(0, 0), cA, voffA); PG8_STAGE(PG8_SB(0, 1), cB + hstep, voffB); PG8_STAGE(PG8_SA(0, 1), cA + hstep, voffA);
        if (wr == 1) PG8_BAR;
        PG8_WAIT_V(4); PG8_BAR;
        PG8_STAGE(PG8_SB(1, 0), cB + kstep, voffB); PG8_STAGE(PG8_SA(1, 0), cA + kstep, voffA); PG8_STAGE(PG8_SB(1, 1), cB + hstep + kstep, voffB);
        PG8_WAIT_V(6); PG8_BAR;
    }
    for (;;) {
        const bool has_next = S.next(ui + 1, nxt);
        const char* nA = has_next ? (const char*)g.A + (size_t)nxt.pm * tstep : cA; const char* nB = has_next ? (const char*)g.Bt + (size_t)nxt.pn * tstep : cB;
        for (int t = 0; t < nt; t += 2) {
            const bool last = (t == nt - 2);
            const char* a1 = cA + (size_t)(t + 1) * kstep;
            const char* a2 = last ? nA : cA + (size_t)(t + 2) * kstep; const char* b2 = last ? nB : cB + (size_t)(t + 2) * kstep;
            const char* a3 = a2 + kstep; const char* b3 = b2 + kstep;
            if (last && has_next) S.a_ready(nxt);
            if constexpr (SP2) {
            PG8_LDB(B0, 0, 0); PG8_LDB(B1, 0, 1); PG8_SCHED; PG8_LDA(At, 0, 0); PG8_STAGE(PG8_SA(1, 1), a1 + hstep, voffA);
            PG8_WAIT_V(8); PG8_WAIT_L(0); PG8_BAR; PG8_MMA(0, 0, At, B0); PG8_MMA(0, 1, At, B1); PG8_BAR; PG8_SCHED;
            PG8_LDA(At, 0, 1); PG8_STAGE(PG8_SB(0, 0), b2, voffB); PG8_STAGE(PG8_SB(0, 1), b2 + hstep, voffB); PG8_STAGE(PG8_SA(0, 0), a2, voffA);
            PG8_WAIT_V(8); PG8_WAIT_L(0); PG8_BAR; PG8_MMA(1, 0, At, B0); PG8_MMA(1, 1, At, B1); PG8_BAR; PG8_SCHED;
            PG8_LDB(B0, 1, 0); PG8_LDB(B1, 1, 1); PG8_SCHED; PG8_LDA(At, 1, 0); PG8_STAGE(PG8_SA(0, 1), a2 + hstep, voffA);
            PG8_WAIT_V(8); PG8_WAIT_L(0); PG8_BAR; PG8_MMA(0, 0, At, B0); PG8_MMA(0, 1, At, B1); PG8_BAR; PG8_SCHED;
            PG8_LDA(At, 1, 1); PG8_STAGE(PG8_SB(1, 0), b3, voffB); PG8_STAGE(PG8_SB(1, 1), b3 + hstep, voffB); PG8_STAGE(PG8_SA(1, 0), a3, voffA);
            PG8_WAIT_V(8); PG8_WAIT_L(0); PG8_BAR; PG8_MMA(1, 0, At, B0); PG8_MMA(1, 1, At, B1); PG8_BAR; PG8_SCHED;
            } else {
            PG8_LDB(B0, 0, 0); PG8_SCHED; PG8_LDA(At, 0, 0); PG8_STAGE(PG8_SA(1, 1), a1 + hstep, voffA);
            PG8_WAIT_L(8); PG8_BAR; PG8_WAIT_L(0); PG8_MMA(0, 0, At, B0); PG8_BAR; PG8_SCHED;
            PG8_LDB(B1, 0, 1); PG8_STAGE(PG8_SB(0, 0), b2, voffB);
            PG8_BAR; PG8_WAIT_L(0); PG8_MMA(0, 1, At, B1); PG8_BAR;
            PG8_LDA(At, 0, 1); PG8_STAGE(PG8_SA(0, 0), a2, voffA);
            PG8_BAR; PG8_WAIT_L(0); PG8_MMA(1, 0, At, B0); PG8_BAR; PG8_SCHED;
            PG8_STAGE(PG8_SB(0, 1), b2 + hstep, voffB);
            PG8_WAIT_V(6); PG8_BAR; PG8_MMA(1, 1, At, B1); PG8_BAR;
            PG8_LDB(B0, 1, 0); PG8_SCHED; PG8_LDA(At, 1, 0); PG8_STAGE(PG8_SA(0, 1), a2 + hstep, voffA);
            PG8_WAIT_L(8); PG8_BAR; PG8_WAIT_L(0); PG8_MMA(0, 0, At, B0); PG8_BAR; PG8_SCHED;
            PG8_LDB(B1, 1, 1); PG8_STAGE(PG8_SB(1, 0), b3, voffB);
            PG8_BAR; PG8_WAIT_L(0); PG8_MMA(0, 1, At, B1); PG8_BAR;
            PG8_LDA(At, 1, 1); PG8_STAGE(PG8_SA(1, 0), a3, voffA);
            PG8_BAR; PG8_WAIT_L(0); PG8_MMA(1, 0, At, B0); PG8_BAR; PG8_SCHED;
            PG8_STAGE(PG8_SB(1, 1), b3 + hstep, voffB);
            PG8_WAIT_V(6); PG8_BAR; PG8_MMA(1, 1, At, B1); PG8_BAR;
            }
        }
        if constexpr (ALIGN_EPI) { if (wr == 0) PG8_BAR; }
        if constexpr (!Epi::AFTER_DRAIN) { E(acc, cur, wr, wc, fr, fq); S.done(cur); }
        if (!has_next) break;
#pragma unroll
        for (int a = 0; a < 2; ++a)
#pragma unroll
            for (int b = 0; b < 2; ++b)
#pragma unroll
                for (int m = 0; m < 4; ++m)
#pragma unroll
                    for (int n = 0; n < 2; ++n) acc[a][b][m][n] = (f32x4){0.f, 0.f, 0.f, 0.f};
        cur = nxt; cA = nA; cB = nB; ++ui;
        if constexpr (ALIGN_EPI) { if (wr == 1) PG8_BAR; }
    }
    PG8_WAIT_V(0);
    if constexpr (!ALIGN_EPI) { if (wr == 0) PG8_BAR; }
    PG8_BAR;
    if constexpr (Epi::AFTER_DRAIN) { E.fused(acc, cur, wr, wc, fr, fq, lds, wid, lane); S.done(cur); }
#undef PG8_SA
#undef PG8_SB
#undef PG8_STAGE
#undef PG8_LDA
#undef PG8_LDB
#undef PG8_MMA
#undef PG8_WAIT_V
#undef PG8_WAIT_L
#undef PG8_BAR
#undef PG8_SCHED
}
}
constexpr int LD_P_ = 2816;
__device__ __forceinline__ unsigned pk2f(float lo, float hi) { return pg8::pk_bf16(lo, hi); }
#define GAS __attribute__((address_space(1)))
#define LAS __attribute__((address_space(3)))
typedef unsigned short bf16;
typedef unsigned v4u __attribute__((ext_vector_type(4)));
typedef unsigned v2u __attribute__((ext_vector_type(2)));
typedef float f32x4 __attribute__((ext_vector_type(4)));
typedef float f32x16 __attribute__((ext_vector_type(16)));
typedef short bf16x8 __attribute__((ext_vector_type(8)));
typedef short s16x4 __attribute__((ext_vector_type(4)));
constexpr int NWAVES = 8, NTHR = 512;
constexpr int DM = 1024, MP = 32768, MS = 512, MT = MP + MS, DFF = 2816, NUP = 5632, NPROJ = 2816, NLAYER = 2;
constexpr int SEQ = 4096, PAST = 4096, DSEQ = 32, NB_P = 8, NB_S = 16;
constexpr float ALPHA = 1.4142135623730951f, LN_EPS = 1e-5f, RMS_EPS = 1e-5f, LOG2E = 1.4426950408889634f;
constexpr float QSCALE = 0.125f * LOG2E;
constexpr int PC_U = 0, PC_UP = 256, PC_B = 512, PC_C = 768, PC_H = 1024, PC_Q = 1280, PC_K = 1792, PC_V = 2304;
constexpr size_t O_Y = 0, O_KP = 34078720, O_VP = 67633152, O_PLP = 101187584, O_CVP = 101249024, O_KS = 101257216, O_VS = 101781504, O_PLS = 102305792, O_CVS = 102428672, O_END = 102445056;
constexpr size_t MiB = 1u << 20;
constexpr size_t WS_XBAR = 65536;
constexpr size_t WS_CTL = 0, WS_LEFTP = 1 * MiB, WS_BT = 1 * MiB + 512 * 1024, WS_WUP = 2 * MiB, WS_WDN = 46 * MiB, WS_WIN = 68 * MiB, WS_WOUT = 79 * MiB,
                 WS_X = 84 * MiB, WS_XB = 214 * MiB, WS_HP = 279 * MiB, WS_MIX = 458 * MiB, WS_PART = 523 * MiB, WS_STATS = 548 * MiB, WS_CGBW = 552 * MiB, WS_END = 560 * MiB;
constexpr size_t SZ_WUP = (size_t)NUP * DM, SZ_WDN = (size_t)DM * DFF, SZ_WIN = (size_t)NPROJ * DM, SZ_WOUT = (size_t)DM * DM;
constexpr int RING_BYTES = 131072, MISC_OFF = RING_BYTES, LDS_BYTES = 155648;
constexpr int L_BT = MISC_OFF, L_Q = MISC_OFF + 2048, L_XB = MISC_OFF + 2304, L_TAB = MISC_OFF + 4096, L_FOLD = MISC_OFF + 12288;
constexpr int NPHASE = 2 + 7 * NLAYER;

struct Params { const float* in[18]; float* out; unsigned char* ws; int ph_lo, ph_hi; };

#define LDS_WAIT() asm volatile("s_waitcnt lgkmcnt(0)" ::: "memory")
__device__ __forceinline__ unsigned f2bf(float f) { unsigned u = __builtin_bit_cast(unsigned, f); return (u + 0x7fffu + ((u >> 16) & 1u)) >> 16; }
__device__ __forceinline__ unsigned pk2(float lo, float hi) { return f2bf(lo) | (f2bf(hi) << 16); }
__device__ __forceinline__ float bf2f(unsigned short h) { return __builtin_bit_cast(float, (unsigned)h << 16); }
__device__ __forceinline__ float bflo(unsigned w) { return __builtin_bit_cast(float, w << 16); }
__device__ __forceinline__ float bfhi(unsigned w) { return __builtin_bit_cast(float, w & 0xffff0000u); }
__device__ __forceinline__ float wave_sum(float v) {
#pragma unroll
    for (int o = 1; o < 64; o <<= 1) v += __shfl_xor(v, o);
    return v;
}

__device__ __forceinline__ void transpose_item(const float* W, int ldw, int K, bf16* WT, int k0, int srccol0, int dstrow0, LAS float* scr, int lane) {
    { const int kr = lane >> 3, c4 = (lane & 7) * 4; f32x4 v[8];
#pragma unroll
      for (int i = 0; i < 8; ++i) v[i] = *(const f32x4*)(W + (size_t)(k0 + 8 * i + kr) * ldw + srccol0 + c4);
#pragma unroll
      for (int i = 0; i < 8; ++i) { LAS float* d = scr + (8 * i + kr) * 33 + c4; d[0] = v[i].x; d[1] = v[i].y; d[2] = v[i].z; d[3] = v[i].w; } }
    LDS_WAIT(); asm volatile("" ::: "memory");
    const int c = lane & 7;
#pragma unroll
    for (int j = 0; j < 4; ++j) { const int n = (lane >> 3) + 8 * j; const LAS float* s = scr + (8 * c) * 33 + n;
        v4u o; o.x = pk2(s[0 * 33], s[1 * 33]); o.y = pk2(s[2 * 33], s[3 * 33]); o.z = pk2(s[4 * 33], s[5 * 33]); o.w = pk2(s[6 * 33], s[7 * 33]);
        *(v4u*)(WT + (size_t)(dstrow0 + n) * K + k0 + 8 * c) = o; }
    LDS_WAIT(); asm volatile("" ::: "memory");
}
__device__ __forceinline__ int t5_bucket(int rel) {
    const int nb = 16, max_exact = 8; int ret = rel > 0 ? nb : 0; const int n = rel < 0 ? -rel : rel;
    if (n < max_exact) return ret + n;
    int j = 0; const long n2 = (long)n * n;
    while (j < 7 && (64L << (j + 1)) <= n2) ++j;
    return ret + max_exact + j;
}
__device__ __forceinline__ void prologue(const Params& P, LAS unsigned char* lds, int G) {
    const int tid = tid_opaque(), lane = tid & 63, wave = __builtin_amdgcn_readfirstlane(tid >> 6);
    const int gw = blockIdx.x * NWAVES + wave, NGW = G * NWAVES;
    unsigned char* ws = P.ws;
    LAS float* scr = (LAS float*)(lds + wave * 16384);
    if (blockIdx.x == 0 && tid < 256) ((unsigned*)(ws + WS_CTL))[tid] = 0u;
    if (blockIdx.x == 0 && wave == 1) {
        for (int l = 0; l < NLAYER; ++l) { const float* dl = P.in[15] + l * 256;
            const float a = wave_sum(dl[lane] * dl[64 + lane]), b = wave_sum(dl[128 + lane] * dl[192 + lane]);
            const float lam_init = 0.8f - 0.6f * expf(-0.3f * (float)l);
            if (lane == 0) ((float*)(ws + WS_CTL))[256 + l] = expf(a) - expf(b) + lam_init; }
    }
    if (blockIdx.x == 1) {
        for (int e = tid; e < 4 * 256; e += NTHR) { const int h = e >> 8, i = e & 255; ((float*)(ws + WS_BT))[e] = P.in[17][t5_bucket(i - 192) * 4 + h] * LOG2E; }
    }
    constexpr int I_UP = 16 * 176, I_DN = 44 * 32, I_IN = 16 * 88, I_OUT = 16 * 32;
    constexpr int NITEMS = 4 * I_UP + 4 * I_DN + 2 * I_IN + 2 * I_OUT;
    for (int it = gw; it < NITEMS; it += NGW) {
        int r = it;
        if (r < 4 * I_UP) { const int mi = r / I_UP, q = r % I_UP, kb = q / 176, nb = q % 176; const int n0 = nb * 32, t = n0 >> 8, c = n0 & 255;
            const int src0 = (c < 128) ? 128 * t + c : DFF + 128 * t + (c - 128);
            transpose_item(P.in[8] + (size_t)mi * DM * NUP, NUP, DM, (bf16*)(ws + WS_WUP) + (size_t)mi * SZ_WUP, kb * 64, src0, n0, scr, lane); continue; }
        r -= 4 * I_UP;
        if (r < 4 * I_DN) { const int mi = r / I_DN, q = r % I_DN, kb = q / 32, nb = q % 32;
            transpose_item(P.in[9] + (size_t)mi * DFF * DM, DM, DFF, (bf16*)(ws + WS_WDN) + (size_t)mi * SZ_WDN, kb * 64, nb * 32, nb * 32, scr, lane); continue; }
        r -= 4 * I_DN;
        if (r < 2 * I_IN) { const int mi = r / I_IN, q = r % I_IN, kb = q / 88, nb = q % 88; const int n0 = nb * 32;
            if (n0 >= 256 && n0 < 512) continue;
            const int src0 = n0 < 256 ? n0 : n0 - 256;
            transpose_item(P.in[10] + (size_t)mi * DM * 2560, 2560, DM, (bf16*)(ws + WS_WIN) + (size_t)mi * SZ_WIN, kb * 64, src0, n0, scr, lane); continue; }
        r -= 2 * I_IN;
        { const int mi = r / I_OUT, q = r % I_OUT, kb = q / 32, nb = q % 32;
            transpose_item(P.in[11] + (size_t)mi * DM * DM, DM, DM, (bf16*)(ws + WS_WOUT) + (size_t)mi * SZ_WOUT, kb * 64, nb * 32, nb * 32, scr, lane); }
    }
    for (int it = gw; it < NLAYER * 4 * 128; it += NGW) {
        const int l = it >> 9, g = (it >> 7) & 3, k0 = (it & 127) * 8;
        const float* pw = P.in[12] + (size_t)(l * 4 + g) * 4096; const float* wi = P.in[10] + (size_t)l * DM * 2560 + g * 64;
        float a[8];
#pragma unroll
        for (int j = 0; j < 8; ++j) a[j] = 0.f;
        for (int c = 0; c < 64; ++c) { const float w = pw[c * 64 + lane];
#pragma unroll
            for (int j = 0; j < 8; ++j) a[j] += wi[(size_t)(k0 + j) * 2560 + c] * w; }
        const float sc = P.in[13][l * 256 + g * 64 + lane];
        v4u o; o.x = pk2(a[0] * sc, a[1] * sc); o.y = pk2(a[2] * sc, a[3] * sc); o.z = pk2(a[4] * sc, a[5] * sc); o.w = pk2(a[6] * sc, a[7] * sc);
        *(v4u*)((bf16*)(ws + WS_WIN) + (size_t)l * SZ_WIN + (size_t)(256 + g * 64 + lane) * DM + k0) = o;
    }
    for (int it = gw; it < NLAYER * NB_S * 15 * 4; it += NGW) {
        const int g = it & 3, rj = it >> 2, l = rj / (NB_S * 15);
        const float* pw = P.in[12] + (size_t)(l * 4 + g) * 4096; const float* st = P.in[4] + (size_t)rj * 256 + g * 64;
        float a = 0.f;
        for (int c = 0; c < 64; ++c) a += st[c] * pw[c * 64 + lane];
        ((float*)(ws + WS_LEFTP))[(size_t)rj * 256 + g * 64 + lane] = a * P.in[13][l * 256 + g * 64 + lane];
    }
    {
        LAS float* red = (LAS float*)lds;
        __syncthreads();
        for (int it = blockIdx.x; it < 5 * 22; it += G) {
            const int ci = it / 22, nb = it % 22, c = ci + 1, l = c / 3, kind = c % 3;
            if (kind == 1 && (nb >= 11 || nb == 1)) continue;
            const int lni = kind == 0 ? (l - 1) * 3 + 2 : kind == 1 ? l * 3 : l * 3 + 1;
            const float* gvec = P.in[6] + (size_t)lni * DM; const float* bvec = P.in[7] + (size_t)lni * DM;
            const float* W; int ldw, src; const int n0 = nb * 256, cc = lane * 4;
            if (kind == 1) { W = P.in[10] + (size_t)l * DM * 2560; ldw = 2560; src = (nb == 0 ? 0 : n0 - 256) + cc; }
            else { W = P.in[8] + (size_t)(l * 2 + (kind == 2)) * DM * NUP; ldw = NUP; src = cc < 128 ? 128 * nb + cc : DFF + 128 * nb + (cc - 128); }
            f32x4 ag = {0.f, 0.f, 0.f, 0.f}, ab = {0.f, 0.f, 0.f, 0.f};
            { const float* wp = W + (size_t)(wave * 128) * ldw + src;
#pragma unroll 16
              for (int k = 0; k < 128; ++k) { const f32x4 w = *(const f32x4*)(wp + (size_t)k * ldw); ag += gvec[wave * 128 + k] * w; ab += bvec[wave * 128 + k] * w; } }
#pragma unroll
            for (int e = 0; e < 4; ++e) { red[((wave * 256) + cc + e) * 2] = ag[e]; red[((wave * 256) + cc + e) * 2 + 1] = ab[e]; }
            __syncthreads();
            float* cgp = (float*)(ws + WS_CGBW) + (size_t)c * 2 * NUP;
            LAS float* tg = red + 4096;
            if (tid < 256) { float sg = 0.f, sb = 0.f;
#pragma unroll
                for (int w8 = 0; w8 < 8; ++w8) { sg += red[(w8 * 256 + tid) * 2]; sb += red[(w8 * 256 + tid) * 2 + 1]; }
                cgp[n0 + tid] = sg; cgp[NUP + n0 + tid] = sb; tg[tid * 2] = sg; tg[tid * 2 + 1] = sb; }
            __syncthreads();
            if (kind == 1 && nb == 0 && tid < 256) {
                const int gi = tid >> 6, d = tid & 63; const float* pw = P.in[12] + (size_t)(l * 4 + gi) * 4096; float pg = 0.f, pb = 0.f;
                for (int q = 0; q < 64; ++q) { const float w = pw[q * 64 + d]; pg += tg[(gi * 64 + q) * 2] * w; pb += tg[(gi * 64 + q) * 2 + 1] * w; }
                const float sc = P.in[13][l * 256 + tid];
                cgp[256 + tid] = pg * sc; cgp[NUP + 256 + tid] = pb * sc;
            }
            __syncthreads();
        }
    }
    for (int m = gw; m < MT; m += 2 * NGW) {
        const int m2 = m + NGW; const bool h2 = m2 < MT;
        const float* src = (m < MP) ? P.in[0] + (size_t)m * DM : P.in[1] + (size_t)(m - MP) * DM;
        const float* src2 = h2 ? ((m2 < MP) ? P.in[0] + (size_t)m2 * DM : P.in[1] + (size_t)(m2 - MP) * DM) : src;
        const f32x4* xr = (const f32x4*)src + lane; const f32x4* xr2 = (const f32x4*)src2 + lane;
        f32x4 va[4], vb[4];
#pragma unroll
        for (int j = 0; j < 4; ++j) { va[j] = xr[64 * j]; vb[j] = xr2[64 * j]; }
        v2u* bo = (v2u*)((bf16*)(ws + WS_XB) + (size_t)m * DM) + lane; v2u* bo2 = (v2u*)((bf16*)(ws + WS_XB) + (size_t)m2 * DM) + lane;
#pragma unroll
        for (int j = 0; j < 4; ++j) { v2u w; w.x = pk2(va[j].x, va[j].y); w.y = pk2(va[j].z, va[j].w); bo[64 * j] = w;
            if (h2) { v2u z; z.x = pk2(vb[j].x, vb[j].y); z.y = pk2(vb[j].z, vb[j].w); bo2[64 * j] = z; } }
    }
}
__device__ __forceinline__ void ln_pass(const Params& P, int gw0, int NGW, int row0, int row1, const float* g, const float* b, float* dst, bool write_xb) {
    const int tid = tid_opaque(), lane = tid & 63, wave = __builtin_amdgcn_readfirstlane(tid >> 6);
    const int gw = gw0 + wave;
    f32x4 gv[4], bv[4];
#pragma unroll
    for (int j = 0; j < 4; ++j) { gv[j] = ((const f32x4*)g)[lane + 64 * j]; bv[j] = ((const f32x4*)b)[lane + 64 * j]; }
    float* stats = (float*)(P.ws + WS_STATS);
    for (int m = row0 + gw; m < row1; m += NGW) {
        const f32x4* xr = (const f32x4*)((const float*)(P.ws + WS_X) + (size_t)m * DM) + lane;
        f32x4 v[4]; float s = 0.f;
#pragma unroll
        for (int j = 0; j < 4; ++j) { v[j] = xr[64 * j]; s += (v[j].x + v[j].y) + (v[j].z + v[j].w); }
        const float mean = wave_sum(s) * (1.f / DM); float s2 = 0.f;
#pragma unroll
        for (int j = 0; j < 4; ++j) { v[j] = v[j] - mean; s2 += (v[j].x * v[j].x + v[j].y * v[j].y) + (v[j].z * v[j].z + v[j].w * v[j].w); }
        const float rstd = 1.f / sqrtf(wave_sum(s2) * (1.f / DM) + LN_EPS);
        if (dst) { f32x4* xo = (f32x4*)(dst + (size_t)m * DM) + lane;
#pragma unroll
            for (int j = 0; j < 4; ++j) xo[64 * j] = v[j] * rstd * gv[j] + bv[j]; }
        if (write_xb) { v2u* bo = (v2u*)((bf16*)(P.ws + WS_XB) + (size_t)m * DM) + lane;
            if (lane == 0) { stats[2 * m] = mean; stats[2 * m + 1] = rstd; }
#pragma unroll
            for (int j = 0; j < 4; ++j) { const f32x4 o = v[j] * rstd * gv[j] + bv[j]; v2u w; w.x = pk2(o.x, o.y); w.y = pk2(o.z, o.w); bo[64 * j] = w; } }
    }
}

__device__ __forceinline__ void final_ln(const Params& P, int G, const float* sp, const float* g, const float* b, float* dst) {
    const int tid = tid_opaque(), lane = tid & 63, wave = __builtin_amdgcn_readfirstlane(tid >> 6);
    const int gw = blockIdx.x * NWAVES + wave, NGW = G * NWAVES;
    f32x4 gv[4], bv[4];
#pragma unroll
    for (int j = 0; j < 4; ++j) { gv[j] = ((const f32x4*)g)[lane + 64 * j]; bv[j] = ((const f32x4*)b)[lane + 64 * j]; }
    for (int m = gw; m < MT; m += NGW) {
        const f32x4 a = *(const f32x4*)(sp + (size_t)m * 8), c = *(const f32x4*)(sp + (size_t)m * 8 + 4);
        const float s1 = (a[0] + a[2]) + (c[0] + c[2]), s2 = (a[1] + a[3]) + (c[1] + c[3]);
        const float mean = s1 * (1.0f / DM), var = s2 * (1.0f / DM) - mean * mean, rstd = 1.0f / sqrtf(var + LN_EPS);
        const v2u* xb = (const v2u*)((const bf16*)(P.ws + WS_XB) + (size_t)m * DM) + lane;
        f32x4* xo = (f32x4*)(dst + (size_t)m * DM) + lane;
#pragma unroll
        for (int j = 0; j < 4; ++j) { const v2u w = xb[64 * j]; const f32x4 v = {bflo(w.x), bfhi(w.x), bflo(w.y), bfhi(w.y)};
            xo[64 * j] = (v - mean * gv[j]) * rstd + bv[j]; }
    }
}
#define RLX_AGENT __ATOMIC_RELAXED, __HIP_MEMORY_SCOPE_AGENT
#define LDS_WAIT() asm volatile("s_waitcnt lgkmcnt(0)" ::: "memory")
#define VM_WAIT() asm volatile("s_waitcnt vmcnt(0)" ::: "memory")
#define XB_TMO      128
#define XB_XCNT(j)  (256  + 64 * (j))
#define XB_XSUB(j)  (1280 + 64 * (j))
#define XB_XGEN(j)  (2304 + 64 * (j))
#define XB_TOP      3328
#define XB_TOPGEN   3392
#define XCD_BAR_WORDS 3456
#define XB_SPIN_CAP (1u << 18)

__device__ __forceinline__ unsigned xb_ld(unsigned* p)              { return __hip_atomic_load(p, __ATOMIC_RELAXED, __HIP_MEMORY_SCOPE_AGENT); }
__device__ __forceinline__ unsigned xb_add(unsigned* p, unsigned v) { return __hip_atomic_fetch_add(p, v, __ATOMIC_RELAXED, __HIP_MEMORY_SCOPE_AGENT); }
__device__ __forceinline__ unsigned xb_xcc_id() { return (unsigned)__builtin_amdgcn_s_getreg((3 << 11) | 20) & 0xFu; }
#define XB_SPIN(cond, bar) do { unsigned _sp = 0; while (cond) { __builtin_amdgcn_s_sleep(1); \
    if ((++_sp & 255u) == 0u) { if (xb_ld(&(bar)[XB_TMO])) break; if (_sp > XB_SPIN_CAP) { atomicAdd(&(bar)[XB_TMO], 1u); break; } } } } while (0)

struct XcdBarrier {
    unsigned* bar; unsigned x;
    volatile LAS unsigned* st;
};

__device__ __forceinline__ XcdBarrier xcd_barrier_post(unsigned* bar, volatile LAS unsigned* st) {
    XcdBarrier b; b.bar = bar; b.x = xb_xcc_id(); b.st = st;
    if (threadIdx.x == 0) (void)xb_add(&bar[XB_XCNT(b.x)], 1u);
    return b;
}
__device__ __forceinline__ void xcd_barrier_complete(unsigned* bar, unsigned x, unsigned& nloc, unsigned& nx) {
    const unsigned G = gridDim.x * gridDim.y * gridDim.z;
    unsigned sum, cnt, mine, sp = 0u;
    for (;;) {
        sum = 0u; cnt = 0u; mine = 0u;
#pragma unroll
        for (unsigned j = 0; j < 16; ++j) { const unsigned c = xb_ld(&bar[XB_XCNT(j)]); sum += c; cnt += (c > 0u) ? 1u : 0u; mine = (j == x) ? c : mine; }
        if (sum == G) break;
        __builtin_amdgcn_s_sleep(1);
        if ((++sp & 255u) == 0u) { if (xb_ld(&bar[XB_TMO])) break; if (sp > XB_SPIN_CAP) { atomicAdd(&bar[XB_TMO], 1u); break; } }
    }
    nloc = mine > 0u ? mine : 1u; nx = cnt > 0u ? cnt : 1u;
}

__device__ __forceinline__ void xcd_barrier(const XcdBarrier& b) {
    asm volatile("s_waitcnt vmcnt(0)" ::: "memory");
    __syncthreads();
    if (threadIdx.x == 0) {
        unsigned* bar = b.bar;
        __builtin_amdgcn_s_waitcnt(0);
        unsigned nloc = b.st[0], nx = b.st[1];
        if (nloc == 0u) { xcd_barrier_complete(bar, b.x, nloc, nx); b.st[0] = nloc; b.st[1] = nx; }
        const unsigned old = xb_add(&bar[XB_XSUB(b.x)], 1u);
        const unsigned gen = old / nloc;
        if (old + 1u == (gen + 1u) * nloc) {
            __builtin_amdgcn_fence(__ATOMIC_RELEASE, "agent");
            asm volatile("s_waitcnt vmcnt(0)" ::: "memory");
            const unsigned og = xb_add(&bar[XB_TOP], 1u);
            const unsigned tg = og / nx;
            if (og + 1u == (tg + 1u) * nx) xb_add(&bar[XB_TOPGEN], 1u);
            else XB_SPIN(xb_ld(&bar[XB_TOPGEN]) == tg, bar);
            __builtin_amdgcn_fence(__ATOMIC_ACQUIRE, "agent");
            xb_add(&bar[XB_XGEN(b.x)], 1u);
            asm volatile("s_waitcnt vmcnt(0)" ::: "memory");
        } else {
            XB_SPIN(xb_ld(&bar[XB_XGEN(b.x)]) == gen, bar);
            __builtin_amdgcn_fence(__ATOMIC_ACQUIRE, "agent");
            asm volatile("s_waitcnt vmcnt(0)" ::: "memory");
        }
    }
    __syncthreads();
}
__device__ __forceinline__ int crow(int r, int hi) { return (r & 3) + 8 * (r >> 2) + 4 * hi; }
__device__ __forceinline__ unsigned off_b(unsigned row, unsigned ch) { return 256u * row + 16u * (ch ^ (((row & 3) << 2) | ((row >> 2) & 3))); }
typedef short v4i16_t __attribute__((ext_vector_type(4)));
__device__ __forceinline__ s16x4 vtr(LAS unsigned char* p) { return __builtin_bit_cast(s16x4, __builtin_amdgcn_ds_read_tr16_b64_v4i16((LAS v4i16_t*)p)); }
constexpr float NEG_BIG = -1e30f;
__device__ __forceinline__ float max3f(float a, float b, float c) { float r; asm("v_max3_f32 %0, %1, %2, %3" : "=v"(r) : "v"(a), "v"(b), "v"(c)); return r; }
constexpr int KT_NEW = 64;
__device__ __forceinline__ void attn_finalize(LAS unsigned char* lds, const Params& P, int l, int h, size_t grow, int comp, int rg, int lane, bool active, f32x16 (&O)[4], float l_tot) {
    const int hi = lane >> 5;
    const float lam = ((const float*)(P.ws + WS_CTL))[256 + l];
    const float lam_init = 0.8f - 0.6f * expf(-0.3f * (float)l);
    const float inv = active ? 1.0f / l_tot : 0.f;
    LAS float* EX = (LAS float*)(lds + 65536 + rg * 16384);
    if (comp == 1 && active) {
        const float f = inv * lam;
#pragma unroll
        for (int c = 0; c < 4; ++c)
#pragma unroll
            for (int r = 0; r < 16; ++r) EX[(c * 16 + r) * 64 + lane] = O[c][r] * f;
    }
    __syncthreads();
    if (comp == 0 && active) {
        float ss = 0.f;
#pragma unroll
        for (int c = 0; c < 4; ++c)
#pragma unroll
            for (int r = 0; r < 16; ++r) { const float o = O[c][r] * inv - EX[(c * 16 + r) * 64 + lane]; O[c][r] = o; ss += o * o; }
        ss += __shfl_xor(ss, 32);
        const float rms = (1.0f - lam_init) / sqrtf(ss * (1.0f / 128.0f) + RMS_EPS);
        const float* sg = P.in[16] + l * 128;
        bf16* mp = (bf16*)(P.ws + WS_MIX) + grow * DM + 512 + h * 128;
#pragma unroll
        for (int c = 0; c < 4; ++c)
#pragma unroll
            for (int g4 = 0; g4 < 4; ++g4) { const int d = 32 * c + 8 * g4 + 4 * hi; const f32x4 gg = *(const f32x4*)(sg + d);
                v2u w; w.x = pk2f(O[c][4 * g4 + 0] * rms * gg.x, O[c][4 * g4 + 1] * rms * gg.y); w.y = pk2f(O[c][4 * g4 + 2] * rms * gg.z, O[c][4 * g4 + 3] * rms * gg.w);
                *(v2u*)(mp + d) = w; }
    }
    __syncthreads();
}
constexpr int PART_STRIDE = 64 * 64 + 128;
__device__ __forceinline__ void attn_combine(LAS unsigned char* lds, const Params& P, int l, int b, int h) {
    const int tid = tid_opaque(), lane = tid & 63, wid = __builtin_amdgcn_readfirstlane(tid >> 6), comp = wid & 1, rg = wid >> 1, r32 = lane & 31;
    const bool active = rg == 0;
    f32x16 O[4];
#pragma unroll
    for (int c = 0; c < 4; ++c) O[c] = (f32x16){};
    float l_tot = 1.f;
    if (active) {
        const float* pb = (const float*)(P.ws + WS_PART) + (size_t)((((l * NB_S + b) * 4 + h) * 4) * 2 + comp) * PART_STRIDE;
        float m[4], mstar = NEG_BIG;
#pragma unroll
        for (int sp = 0; sp < 4; ++sp) { m[sp] = pb[(size_t)sp * 2 * PART_STRIDE + 4096 + lane]; mstar = fmaxf(mstar, m[sp]); }
        l_tot = 0.f;
#pragma unroll
        for (int sp = 0; sp < 4; ++sp) { const float f = __builtin_amdgcn_exp2f(m[sp] - mstar); const float* q = pb + (size_t)sp * 2 * PART_STRIDE;
            l_tot += q[4096 + 64 + lane] * f;
#pragma unroll
            for (int c = 0; c < 4; ++c)
#pragma unroll
                for (int r = 0; r < 16; ++r) O[c][r] += q[(c * 16 + r) * 64 + lane] * f; }
    }
    attn_finalize(lds, P, l, h, (size_t)(MP + b * DSEQ + r32), comp, rg, lane, active, O, l_tot);
}
template <bool SAMPLE>
__device__ __forceinline__ void attn_unit(LAS unsigned char* lds, const Params& P, int l, int b, int h, int qb) {
    const int tid = tid_opaque(), lane = tid & 63, wid = __builtin_amdgcn_readfirstlane(tid >> 6), comp = wid & 1, rg = wid >> 1, r32 = lane & 31, hi = lane >> 5;
    const bf16* PROJ = (const bf16*)(P.ws + WS_HP);
    const int KT0 = 0, NT = SAMPLE ? 65 : 2 * qb + 2;
    const int q0 = SAMPLE ? 0 : qb * 128 + rg * 32;
    const int qpos0 = SAMPLE ? PAST : q0;
    const int nt_w = SAMPLE ? NT : (q0 >> 6) + 1;
    const size_t grow = SAMPLE ? (size_t)(MP + b * DSEQ + r32) : (size_t)(b * SEQ + q0 + r32);
    bf16x8 qf[4];
#pragma unroll
    for (int ks = 0; ks < 4; ++ks) qf[ks] = *(const bf16x8*)(PROJ + grow * LD_P_ + PC_Q + h * 128 + comp * 64 + ks * 16 + hi * 8);
    unsigned kaddr[4], vaddr[4][2];
    { const unsigned xk = ((r32 & 3) << 2) | ((r32 >> 2) & 3);
#pragma unroll
      for (int ks = 0; ks < 4; ++ks) kaddr[ks] = 256u * r32 + 16u * ((unsigned)(8 * comp + 2 * ks + hi) ^ xk);
      const unsigned blk = (lane >> 4) & 1, q = (lane & 15) >> 2, p = lane & 3;
#pragma unroll
      for (int c = 0; c < 4; ++c)
#pragma unroll
          for (int t = 0; t < 2; ++t) vaddr[c][t] = off_b(8 * t + 4 * hi + q, 4 * c + 2 * blk + (p >> 1)) + 8 * (p & 1); }
    const int crow0 = tid >> 4, cch = tid & 15;
    const unsigned sdst0 = off_b(crow0, cch), sdst1 = off_b(crow0 + 32, cch);
    v4u stg[4];
    f32x4 raw[8];
    const float* ckb = SAMPLE ? P.in[2] + ((size_t)(l * NB_S + b) * PAST * 4 + h) * 128 + cch * 8 : nullptr;
    const float* cvb = SAMPLE ? P.in[3] + ((size_t)(l * NB_S + b) * PAST * 4 + h) * 128 + cch * 8 : nullptr;
    const float* nkb = SAMPLE ? P.out + O_KS + ((size_t)(l * NB_S + b) * DSEQ * 4 + h) * 128 + cch * 8 : nullptr;
    const float* nvb = SAMPLE ? P.out + O_VS + ((size_t)(l * NB_S + b) * DSEQ * 4 + h) * 128 + cch * 8 : nullptr;
    const bf16* pkb = PROJ + (size_t)(b * SEQ) * LD_P_ + PC_K + h * 128 + cch * 8;
    const bf16* pvb = PROJ + (size_t)(b * SEQ) * LD_P_ + PC_V + h * 128 + cch * 8;
#define ATT_LOAD(kt) do { \
    if (SAMPLE) { _Pragma("unroll") for (int i_ = 0; i_ < 2; ++i_) { const int row_ = crow0 + 32 * i_; \
            if ((kt) < 64) { const float* a_ = ckb + (size_t)((kt) * 64 + row_) * 512; const float* b_ = cvb + (size_t)((kt) * 64 + row_) * 512; \
                raw[4 * i_ + 0] = *(const f32x4*)a_; raw[4 * i_ + 1] = *(const f32x4*)(a_ + 4); raw[4 * i_ + 2] = *(const f32x4*)b_; raw[4 * i_ + 3] = *(const f32x4*)(b_ + 4); } \
            else if (row_ < DSEQ) { const float* a_ = nkb + (size_t)row_ * 512; const float* b_ = nvb + (size_t)row_ * 512; \
                raw[4 * i_ + 0] = *(const f32x4*)a_; raw[4 * i_ + 1] = *(const f32x4*)(a_ + 4); raw[4 * i_ + 2] = *(const f32x4*)b_; raw[4 * i_ + 3] = *(const f32x4*)(b_ + 4); } \
            else { raw[4 * i_ + 0] = (f32x4){0.f, 0.f, 0.f, 0.f}; raw[4 * i_ + 1] = (f32x4){0.f, 0.f, 0.f, 0.f}; raw[4 * i_ + 2] = (f32x4){0.f, 0.f, 0.f, 0.f}; raw[4 * i_ + 3] = (f32x4){0.f, 0.f, 0.f, 0.f}; } } } \
    else { _Pragma("unroll") for (int i_ = 0; i_ < 2; ++i_) { const size_t ro_ = (size_t)((kt) * 64 + crow0 + 32 * i_) * LD_P_; \
            stg[2 * i_ + 0] = *(const v4u*)(pkb + ro_); stg[2 * i_ + 1] = *(const v4u*)(pvb + ro_); } } } while (0)
#define CVT8F(lo_, hi_) ((v4u){pk2f((lo_).x, (lo_).y), pk2f((lo_).z, (lo_).w), pk2f((hi_).x, (hi_).y), pk2f((hi_).z, (hi_).w)})
#define ATT_STORE(s) do { LAS unsigned char* kb_ = lds + (s) * 32768; \
    if (SAMPLE) { stg[0] = CVT8F(raw[0], raw[1]); stg[1] = CVT8F(raw[2], raw[3]); stg[2] = CVT8F(raw[4], raw[5]); stg[3] = CVT8F(raw[6], raw[7]); } \
    *(LAS v4u*)(kb_ + sdst0) = stg[0]; *(LAS v4u*)(kb_ + 16384 + sdst0) = stg[1]; *(LAS v4u*)(kb_ + sdst1) = stg[2]; *(LAS v4u*)(kb_ + 16384 + sdst1) = stg[3]; } while (0)
    const LAS float* BT = (const LAS float*)(lds + L_BT);
    if (tid < 256) ((LAS float*)(lds + L_BT))[tid] = ((const float*)(P.ws + WS_BT))[h * 256 + tid];
    const float cfar = ((const float*)(P.ws + WS_BT))[h * 256];
    f32x16 O[4];
#pragma unroll
    for (int c = 0; c < 4; ++c) O[c] = (f32x16){};
    float m_run = NEG_BIG, l_run = 0.f;
    ATT_LOAD(KT0); ATT_STORE(0);
    __syncthreads();
    for (int kt = KT0; kt < NT; ++kt) {
        if (kt + 1 < NT) ATT_LOAD(kt + 1);
        if (kt < nt_w && (!SAMPLE || (kt & 3) == rg)) {
            LAS unsigned char* Kb = lds + ((kt - KT0) & 1) * 32768; LAS unsigned char* Vb = Kb + 16384;
            const bool far = (qpos0 - (kt * 64 + 63)) >= 91;
            const float ini = far ? cfar : 0.f;
            f32x16 p0, p1;
#pragma unroll
            for (int r = 0; r < 16; ++r) { p0[r] = ini; p1[r] = ini; }
            {
                bf16x8 kf[8];
#pragma unroll
                for (int ks = 0; ks < 4; ++ks) { kf[2 * ks] = *(const LAS bf16x8*)(Kb + kaddr[ks]); kf[2 * ks + 1] = *(const LAS bf16x8*)(Kb + kaddr[ks] + 8192); }
                __builtin_amdgcn_sched_barrier(0);
#pragma unroll
                for (int ks = 0; ks < 4; ++ks) {
                    p0 = __builtin_amdgcn_mfma_f32_32x32x16_bf16(kf[2 * ks], qf[ks], p0, 0, 0, 0);
                    p1 = __builtin_amdgcn_mfma_f32_32x32x16_bf16(kf[2 * ks + 1], qf[ks], p1, 0, 0, 0);
                }
            }
            s16x4 va[8], vb[8];
#define VLOAD(dst, s_) do { _Pragma("unroll") for (int c_ = 0; c_ < 4; ++c_) { dst[2 * c_] = vtr(Vb + vaddr[c_][0] + 4096 * (s_)); dst[2 * c_ + 1] = vtr(Vb + vaddr[c_][1] + 4096 * (s_)); } } while (0)
#define VFRAG(src, c_) ((bf16x8){src[2 * (c_)][0], src[2 * (c_)][1], src[2 * (c_)][2], src[2 * (c_)][3], src[2 * (c_) + 1][0], src[2 * (c_) + 1][1], src[2 * (c_) + 1][2], src[2 * (c_) + 1][3]})
            VLOAD(va, 0);
            __builtin_amdgcn_sched_barrier(0);
            if (!far) { const int ib = kt * 64 - (qpos0 + r32) + 192 + 4 * hi;
#pragma unroll
                for (int r = 0; r < 16; ++r) { const int o = (r & 3) + 8 * (r >> 2); p0[r] += BT[ib + o]; p1[r] += BT[ib + o + 32]; } }
            if (SAMPLE && kt == KT_NEW) {
#pragma unroll
                for (int r = 0; r < 16; ++r) p1[r] = NEG_BIG; }
            float mx = NEG_BIG, mx2 = NEG_BIG;
#pragma unroll
            for (int r = 0; r < 16; r += 2) { mx = max3f(mx, p0[r], p0[r + 1]); mx2 = max3f(mx2, p1[r], p1[r + 1]); }
            mx = fmaxf(mx, mx2);
            mx = fmaxf(mx, __shfl_xor(mx, 32));
            const float m_new = fmaxf(m_run, mx), alpha = __builtin_amdgcn_exp2f(m_run - m_new);
            const bool resc = m_new > m_run;
            m_run = m_new;
            float ls = 0.f;
#pragma unroll
            for (int r = 0; r < 16; ++r) { p0[r] = __builtin_amdgcn_exp2f(p0[r] - m_new); p1[r] = __builtin_amdgcn_exp2f(p1[r] - m_new); ls += p0[r] + p1[r]; }
            l_run = l_run * alpha + ls;
            if (__any(resc)) {
#pragma unroll
                for (int c = 0; c < 4; ++c)
#pragma unroll
                    for (int r = 0; r < 16; ++r) O[c][r] *= alpha;
            }
            v4u pw[4];
            pw[0] = (v4u){pk2f(p0[0], p0[1]), pk2f(p0[2], p0[3]), pk2f(p0[4], p0[5]), pk2f(p0[6], p0[7])};
            pw[1] = (v4u){pk2f(p0[8], p0[9]), pk2f(p0[10], p0[11]), pk2f(p0[12], p0[13]), pk2f(p0[14], p0[15])};
            pw[2] = (v4u){pk2f(p1[0], p1[1]), pk2f(p1[2], p1[3]), pk2f(p1[4], p1[5]), pk2f(p1[6], p1[7])};
            pw[3] = (v4u){pk2f(p1[8], p1[9]), pk2f(p1[10], p1[11]), pk2f(p1[12], p1[13]), pk2f(p1[14], p1[15])};
            __builtin_amdgcn_sched_barrier(0);
#define PVSTEP(cur, nxt, s_) do { if ((s_) < 3) VLOAD(nxt, (s_) + 1); __builtin_amdgcn_sched_barrier(0); \
                const bf16x8 pf_ = __builtin_bit_cast(bf16x8, pw[s_]); \
                _Pragma("unroll") for (int c_ = 0; c_ < 4; ++c_) O[c_] = __builtin_amdgcn_mfma_f32_32x32x16_bf16(VFRAG(cur, c_), pf_, O[c_], 0, 0, 0); \
                __builtin_amdgcn_sched_barrier(0); } while (0)
            PVSTEP(va, vb, 0); PVSTEP(vb, va, 1); PVSTEP(va, vb, 2); PVSTEP(vb, va, 3);
#undef PVSTEP
#undef VLOAD
#undef VFRAG
        }
        if (kt + 1 < NT) ATT_STORE((kt + 1 - KT0) & 1);
        __syncthreads();
    }
#undef ATT_LOAD
#undef ATT_STORE
#undef CVT8F
    const bool active = true;
    const float l_tot = l_run + __shfl_xor(l_run, 32);
    if (SAMPLE) {
        if (active) { float* pb = (float*)(P.ws + WS_PART) + (size_t)(((((l * NB_S + b) * 4 + h) * 4) + rg) * 2 + comp) * PART_STRIDE;
#pragma unroll
            for (int c = 0; c < 4; ++c)
#pragma unroll
                for (int r = 0; r < 16; ++r) pb[(c * 16 + r) * 64 + lane] = O[c][r];
            pb[4096 + lane] = m_run; pb[4096 + 64 + lane] = l_tot; }
        __syncthreads();
    } else attn_finalize(lds, P, l, h, grow, comp, rg, lane, active, O, l_tot);
}

__device__ __forceinline__ void load8(const bf16* p, float (&v)[8]) { const v4u w = *(const v4u*)p; v[0] = bflo(w.x); v[1] = bfhi(w.x); v[2] = bflo(w.y); v[3] = bfhi(w.y); v[4] = bflo(w.z); v[5] = bfhi(w.z); v[6] = bflo(w.w); v[7] = bfhi(w.w); }
__device__ __forceinline__ void loadf8(const float* p, float (&v)[8]) { const f32x4 a = *(const f32x4*)p, b = *(const f32x4*)(p + 4); v[0] = a.x; v[1] = a.y; v[2] = a.z; v[3] = a.w; v[4] = b.x; v[5] = b.y; v[6] = b.z; v[7] = b.w; }
__device__ __forceinline__ void unpack8(const v4u w, float (&v)[8]) { v[0] = bflo(w.x); v[1] = bfhi(w.x); v[2] = bflo(w.y); v[3] = bfhi(w.y); v[4] = bflo(w.z); v[5] = bfhi(w.z); v[6] = bflo(w.w); v[7] = bfhi(w.w); }
template <int W>
__device__ __forceinline__ void pool_rows(const Params& P, int l, bool smp, int seq, int s0, int nrow, size_t rowbase, int ch, int rl) {
    const bf16* PROJ = (const bf16*)(P.ws + WS_HP); bf16* MIX = (bf16*)(P.ws + WS_MIX);
    const float* leftp = (const float*)(P.ws + WS_LEFTP) + (size_t)(l * NB_S + seq) * 15 * 256 + ch;
    const int sf = s0 + 4 * rl;
    (void)nrow;
    if (sf >= W - 1) {
        v4u raw[W], nx[3];
#pragma unroll
        for (int j = 0; j < W; ++j) raw[j] = *(const v4u*)(PROJ + (rowbase + sf - j) * LD_P_ + PC_UP + ch);
#pragma unroll
        for (int i = 1; i < 4; ++i) nx[i - 1] = *(const v4u*)(PROJ + (rowbase + sf + i) * LD_P_ + PC_UP + ch);
        float sum[8], cur[8];
#pragma unroll
        for (int e = 0; e < 8; ++e) sum[e] = 0.f;
#pragma unroll
        for (int j = 0; j < W; ++j) { float v[8]; unpack8(raw[j], v);
#pragma unroll
            for (int e = 0; e < 8; ++e) sum[e] += v[e]; }
        const float rc = 1.0f / (float)W;
#pragma unroll
        for (int i = 0; i < 4; ++i) {
            if (i > 0) { float vin[8], vout[8]; unpack8(nx[i - 1], vin); unpack8((W - i >= 0) ? raw[(W - i >= 0) ? W - i : 0] : nx[(i - W - 1 >= 0) ? i - W - 1 : 0], vout);
#pragma unroll
                for (int e = 0; e < 8; ++e) sum[e] += vin[e] - vout[e]; }
            unpack8(i == 0 ? raw[0] : nx[i > 0 ? i - 1 : 0], cur);
            v4u o; o.x = pk2f(sum[0] * rc - cur[0], sum[1] * rc - cur[1]); o.y = pk2f(sum[2] * rc - cur[2], sum[3] * rc - cur[3]);
            o.z = pk2f(sum[4] * rc - cur[4], sum[5] * rc - cur[5]); o.w = pk2f(sum[6] * rc - cur[6], sum[7] * rc - cur[7]);
            *(v4u*)(MIX + (rowbase + sf + i) * DM + ch) = o; }
    } else {
        for (int i = 0; i < 4; ++i) { const int s = sf + i;
            float acc[8], cur[8];
#pragma unroll
            for (int e = 0; e < 8; ++e) { acc[e] = 0.f; cur[e] = 0.f; }
#pragma unroll
            for (int j = 0; j < W; ++j) { const int sj = s - j; float v[8];
                if (sj >= 0) load8(PROJ + (rowbase + sj) * LD_P_ + PC_UP + ch, v);
                else if (smp) loadf8(leftp + (size_t)(15 + sj) * 256, v);
                else {
#pragma unroll
                    for (int e = 0; e < 8; ++e) v[e] = 0.f; }
#pragma unroll
                for (int e = 0; e < 8; ++e) { acc[e] += v[e]; if (j == 0) cur[e] = v[e]; } }
            const int pos = smp ? PAST + s : s; const float rc = 1.0f / (float)(pos + 1 < W ? pos + 1 : W);
            v4u o; o.x = pk2f(acc[0] * rc - cur[0], acc[1] * rc - cur[1]); o.y = pk2f(acc[2] * rc - cur[2], acc[3] * rc - cur[3]);
            o.z = pk2f(acc[4] * rc - cur[4], acc[5] * rc - cur[5]); o.w = pk2f(acc[6] * rc - cur[6], acc[7] * rc - cur[7]);
            *(v4u*)(MIX + (rowbase + s) * DM + ch) = o; }
    }
}
__device__ __forceinline__ void ew_item(const Params& P, int l, int item) {
    const int tid = tid_opaque(), lane = tid & 63, wv = __builtin_amdgcn_readfirstlane(tid >> 6), rl = lane >> 3;
    const bool smp = item >= 1024; const int seq = smp ? item - 1024 : item >> 7, rb = smp ? 0 : item & 127;
    const int S = smp ? DSEQ : SEQ, nrow = 32, s0 = rb * 32;
    const size_t rowbase = smp ? (size_t)(MP + seq * DSEQ) : (size_t)seq * SEQ;
    const bf16* PROJ = (const bf16*)(P.ws + WS_HP); bf16* MIX = (bf16*)(P.ws + WS_MIX);
    if (wv < 4) {
        const int ch = wv * 64 + (lane & 7) * 8;
        if (wv == 0) pool_rows<2>(P, l, smp, seq, s0, nrow, rowbase, ch, rl);
        else if (wv == 1) pool_rows<4>(P, l, smp, seq, s0, nrow, rowbase, ch, rl);
        else if (wv == 2) pool_rows<8>(P, l, smp, seq, s0, nrow, rowbase, ch, rl);
        else pool_rows<16>(P, l, smp, seq, s0, nrow, rowbase, ch, rl);
        if (s0 + nrow == S) {
            float* dst = P.out + (smp ? O_PLS + (size_t)(l * NB_S + seq) * 15 * 256 : O_PLP + (size_t)(l * NB_P + seq) * 15 * 256) + ch;
            for (int j = rl; j < 15; j += 8) { float v[8]; load8(PROJ + (rowbase + S - 15 + j) * LD_P_ + PC_U + ch, v);
                *(f32x4*)(dst + (size_t)j * 256) = (f32x4){v[0], v[1], v[2], v[3]}; *(f32x4*)(dst + (size_t)j * 256 + 4) = (f32x4){v[4], v[5], v[6], v[7]}; } }
    } else {
        const int ch = (wv - 4) * 64 + (lane & 7) * 8;
        const float* cw = P.in[14] + (size_t)l * 3 * 256 + ch; float w0[8], w1[8], w2[8]; loadf8(cw, w0); loadf8(cw + 256, w1); loadf8(cw + 512, w2);
        const float* leftc = P.in[5] + (size_t)(l * NB_S + seq) * 2 * 256 + ch;
        for (int i = 0; i * 8 < nrow; ++i) { const int s = s0 + rl + 8 * i;
            float z[3][8];
#pragma unroll
            for (int j = 0; j < 3; ++j) { const int sj = s - 2 + j;
                if (sj >= 0) { float c[8], hh[8]; load8(PROJ + (rowbase + sj) * LD_P_ + PC_C + ch, c); load8(PROJ + (rowbase + sj) * LD_P_ + PC_H + ch, hh);
#pragma unroll
                    for (int e = 0; e < 8; ++e) z[j][e] = c[e] * hh[e]; }
                else if (smp) loadf8(leftc + (size_t)(2 + sj) * 256, z[j]);
                else {
#pragma unroll
                    for (int e = 0; e < 8; ++e) z[j][e] = 0.f; } }
            float bg[8]; load8(PROJ + (rowbase + s) * LD_P_ + PC_B + ch, bg);
            float y[8];
#pragma unroll
            for (int e = 0; e < 8; ++e) y[e] = bg[e] * (w0[e] * z[0][e] + w1[e] * z[1][e] + w2[e] * z[2][e]);
            v4u o; o.x = pk2f(y[0], y[1]); o.y = pk2f(y[2], y[3]); o.z = pk2f(y[4], y[5]); o.w = pk2f(y[6], y[7]);
            *(v4u*)(MIX + (rowbase + s) * DM + 256 + ch) = o;
            if (s >= S - 2) { float* dst = P.out + (smp ? O_CVS + (size_t)(l * NB_S + seq) * 2 * 256 : O_CVP + (size_t)(l * NB_P + seq) * 2 * 256) + (size_t)(s - (S - 2)) * 256 + ch;
                *(f32x4*)dst = (f32x4){z[2][0], z[2][1], z[2][2], z[2][3]}; *(f32x4*)(dst + 4) = (f32x4){z[2][4], z[2][5], z[2][6], z[2][7]}; } }
    }
}
typedef const __attribute__((address_space(4))) Params* kparams_t;
__device__ __forceinline__ Params load_params() {
#if defined(__HIP_DEVICE_COMPILE__)
    kparams_t p = (kparams_t)__builtin_amdgcn_kernarg_segment_ptr(); asm volatile("" : "+s"(p)); return *p;
#else
    return Params{};
#endif
}
constexpr int NSMP = 8;
__device__ __forceinline__ void sample_subbar(unsigned* ctr, unsigned target) {
    __threadfence();
    __syncthreads();
    if (threadIdx.x == 0) { __hip_atomic_fetch_add(ctr, 1u, __ATOMIC_RELAXED, __HIP_MEMORY_SCOPE_AGENT);
        while (__hip_atomic_load(ctr, __ATOMIC_RELAXED, __HIP_MEMORY_SCOPE_AGENT) < target) __builtin_amdgcn_s_sleep(2); }
    __syncthreads();
    __threadfence();
}
__global__ void __launch_bounds__(NTHR, 2) fwd_megakernel(Params Pk_unused) {
    extern __shared__ __attribute__((aligned(16))) unsigned char lds_raw[];
    LAS unsigned char* lds = (LAS unsigned char*)lds_raw;
    cg::grid_group grid = cg::this_grid();
    const int G = gridDim.x, tid = threadIdx.x;
    if (tid < 8) ((LAS unsigned*)(lds + L_XB))[tid] = 0u;
    __syncthreads();
    XcdBarrier xbar;
    xbar.bar = nullptr; xbar.x = 0; xbar.st = nullptr;
    int lo, hi; { const Params P = load_params(); lo = P.ph_lo; hi = P.ph_hi; }
#define IN(k) (lo <= (k) && (k) < hi)
#if defined(USE_CG_SYNC)
#define SEAM(k) do { if (IN(k) && IN((k) + 1)) grid.sync(); } while (0)
#else
#define SEAM(k) do { if (IN(k) && IN((k) + 1)) xcd_barrier(xbar); } while (0)
#endif
    if (IN(0)) {
#ifndef NO_PRO
        const Params P = load_params(); prologue(P, lds, G);
#ifdef PROBE_PRO2
        __syncthreads(); prologue(P, lds, G);
#endif
#endif
    }
    if (IN(0) && blockIdx.x == 0) { const Params P = load_params(); unsigned* bw_ = (unsigned*)(P.ws + WS_XBAR); for (int i = tid; i < 4096; i += NTHR) bw_[i] = 0u; }
    if (IN(0) && IN(1)) grid.sync();
    { const Params P0 = load_params(); xbar = xcd_barrier_post((unsigned*)(P0.ws + WS_XBAR), (volatile LAS unsigned*)(lds + L_XB)); }
    const bool smpCU = (int)blockIdx.x < NSMP;
    const int pbid = (int)blockIdx.x - NSMP, PG = G - NSMP;
    unsigned sgen = 0;
#define LNP(P_, idx_, ro_) ((idx_) < 0 ? nullptr : (const float*)((P_).ws + WS_STATS) + 2 * (size_t)(ro_)), ((idx_) < 0 ? nullptr : (P_).in[6] + (size_t)(idx_) * DM), ((idx_) < 0 ? nullptr : (P_).in[7] + (size_t)(idx_) * DM)
#define SUBBAR() do { const Params Pq = load_params(); ++sgen; sample_subbar((unsigned*)(Pq.ws + WS_CTL) + 200, sgen * (unsigned)NSMP); } while (0)
#define SPTR(P_, li_, ro_) ((float*)((P_).ws + WS_STATS) + (size_t)((li_) & 1) * MT * 8 + (size_t)(ro_) * 8)
#define LNG(P_, li_) ((P_).in[6] + (size_t)(li_) * DM)
#define LNB(P_, li_) ((P_).in[7] + (size_t)(li_) * DM)
#define CGP(P_, c_) ((const float*)((P_).ws + WS_CGBW) + (size_t)(c_) * 2 * NUP)
#define TABP ((LAS float*)(lds + L_TAB))
#define FOLDP ((LAS float*)(lds + L_FOLD))
#pragma nounroll
    for (int l = 0; l < NLAYER; ++l) {
        const int pb = 1 + 7 * l;
#pragma nounroll
        for (int f = 0; f < 2; ++f) {
            const int p_up = pb + (f ? 5 : 0), p_dn = p_up + 1;
            const int li_in = f ? l * 3 + 1 : l * 3 - 1;
            const int li_out = f ? l * 3 + 2 : l * 3;
            if (IN(p_up)) {
                const int mi = l * 2 + f;
                if (smpCU && f == 1) {
                    { const Params P = load_params(); unsigned char* ws = P.ws;
                      pg8::Gemm g{(const pg8::bf16_t*)(ws + WS_MIX) + (size_t)MP * DM, (const pg8::bf16_t*)(ws + WS_WOUT) + (size_t)l * SZ_WOUT, MS, DM, DM};
                      pg8::FoldOrder S; S.init(MS, DM, NSMP, (int)blockIdx.x); S.sp = SPTR(P, l * 3, MP); S.cg = LNG(P, l * 3); S.bw = LNB(P, l * 3); S.tabs = FOLDP; S.ncall = 0;
                      pg8::EpiRes E{nullptr, nullptr, ALPHA, 1.0f, 1, (pg8::ldsf_t)FOLDP, &S,
                                    SPTR(P, l * 3 + 1, MP), LNG(P, l * 3 + 1), (pg8::bf16_t*)(ws + WS_XB) + (size_t)MP * DM, TABP, 0};
                      pg8::gemm_phase<pg8::EpiRes, pg8::FoldOrder, true, true>(lds, g, S, E); }
                    SUBBAR();
                }
                {
                    const Params P = load_params(); unsigned char* ws = P.ws;
                    const size_t ro = smpCU ? (size_t)MP : 0; const int c = l * 3 + (f ? 2 : 0);
                    pg8::Gemm g{(const pg8::bf16_t*)(ws + WS_XB) + ro * DM, (const pg8::bf16_t*)(ws + WS_WUP) + (size_t)mi * SZ_WUP, smpCU ? MS : MP, NUP, DM};
                    pg8::FoldOrder S; S.init(smpCU ? MS : MP, NUP, smpCU ? NSMP : PG, smpCU ? (int)blockIdx.x : pbid);
                    S.sp = li_in < 0 ? nullptr : (const float*)SPTR(P, li_in, ro); S.cg = CGP(P, c); S.bw = CGP(P, c) + NUP; S.tabs = FOLDP; S.ncall = 0;
                    pg8::EpiGlu E{(pg8::bf16_t*)(ws + WS_HP) + ro * DFF, li_in < 0 ? 0 : 1, (pg8::ldsf_t)FOLDP, &S, 0};
#ifdef PROBE_UP2
                    for (int rep_ = 0; rep_ < 2; ++rep_) { S.ncall = 0; E.nepi = 0; __syncthreads();
#endif
                    pg8::gemm_phase<pg8::EpiGlu, pg8::FoldOrder, true, true>(lds, g, S, E);
#ifdef PROBE_UP2
                    }
#endif
                }
                if (smpCU) {
                    SUBBAR();
                    const Params P = load_params(); unsigned char* ws = P.ws;
                    pg8::Gemm g{(const pg8::bf16_t*)(ws + WS_HP) + (size_t)MP * DFF, (const pg8::bf16_t*)(ws + WS_WDN) + (size_t)mi * SZ_WDN, MS, DM, DFF};
                    pg8::FoldOrder S; S.init(MS, DM, NSMP, (int)blockIdx.x); S.sp = li_in < 0 ? nullptr : (const float*)SPTR(P, li_in, MP); S.cg = li_in < 0 ? nullptr : LNG(P, li_in); S.bw = li_in < 0 ? nullptr : LNB(P, li_in); S.tabs = FOLDP; S.ncall = 0;
                    pg8::EpiRes E{P.in[1], nullptr, ALPHA, 0.5f, li_in < 0 ? 0 : 1, (pg8::ldsf_t)FOLDP, &S,
                                  SPTR(P, li_out, MP), LNG(P, li_out), (pg8::bf16_t*)(ws + WS_XB) + (size_t)MP * DM, TABP, 0};
                    pg8::gemm_phase<pg8::EpiRes, pg8::FoldOrder, true, true>(lds, g, S, E);
                }
            }
            SEAM(p_up);
            if (IN(p_dn)) {
                const int mi = l * 2 + f; const Params P = load_params(); unsigned char* ws = P.ws;
                pg8::Gemm g{(const pg8::bf16_t*)(ws + WS_HP), (const pg8::bf16_t*)(ws + WS_WDN) + (size_t)mi * SZ_WDN, MP, DM, DFF};
                pg8::FoldOrder S; S.init(MP, DM, G, (int)blockIdx.x); S.sp = li_in < 0 ? nullptr : (const float*)SPTR(P, li_in, 0); S.cg = li_in < 0 ? nullptr : LNG(P, li_in); S.bw = li_in < 0 ? nullptr : LNB(P, li_in); S.tabs = FOLDP; S.ncall = 0;
                pg8::EpiRes E{P.in[0], nullptr, ALPHA, 0.5f, li_in < 0 ? 0 : 1, (pg8::ldsf_t)FOLDP, &S,
                              SPTR(P, li_out, 0), LNG(P, li_out), (pg8::bf16_t*)(ws + WS_XB), TABP, 0};
                pg8::gemm_phase<pg8::EpiRes, pg8::FoldOrder, true, true>(lds, g, S, E);
            }
            SEAM(p_dn);
            if (f) break;
            if (IN(pb + 2)) { const Params P = load_params(); unsigned char* ws = P.ws;
                const size_t ro = smpCU ? (size_t)MP : 0; const int c = l * 3 + 1;
                pg8::Gemm g{(const pg8::bf16_t*)(ws + WS_XB) + ro * DM, (const pg8::bf16_t*)(ws + WS_WIN) + (size_t)l * SZ_WIN, smpCU ? MS : MP, NPROJ, DM};
                pg8::FoldOrder S; S.init(smpCU ? MS : MP, NPROJ, smpCU ? NSMP : PG, smpCU ? (int)blockIdx.x : pbid);
                S.sp = (const float*)SPTR(P, l * 3, ro); S.cg = CGP(P, c); S.bw = CGP(P, c) + NUP; S.tabs = FOLDP; S.ncall = 0;
                pg8::EpiProj E{(pg8::bf16_t*)(ws + WS_HP) + ro * NPROJ, QSCALE, P.out, l, smpCU ? 1 : 0, (pg8::ldsf_t)FOLDP, &S, 0};
                pg8::gemm_phase<pg8::EpiProj, pg8::FoldOrder, true, true>(lds, g, S, E);
            }
            SEAM(pb + 2);
            if (IN(pb + 3)) { const Params P = load_params(); unsigned char* ws = P.ws;
                unsigned* ctr = (unsigned*)(ws + WS_CTL) + 64 * l;
                volatile LAS unsigned* qw = (volatile LAS unsigned*)(lds + L_Q);
                constexpr int NU = 64 + 1024 + 1024 + 16;
                for (;;) {
                    if (tid == 0) qw[0] = atomicAdd(ctr, 1u);
                    __syncthreads();
                    const int u = (int)qw[0];
                    __syncthreads();
                    if (u >= NU) break;
                    if (u >= 256 && u < 320) { const int v = u - 256; attn_unit<true>(lds, P, l, v >> 2, v & 3, 0); }
                    else if (u < 64 + 1024) { const int i = u < 256 ? u : u - 64; attn_unit<false>(lds, P, l, (i & 31) >> 2, i & 3, 31 - (i >> 5)); }
                    else ew_item(P, l, u - 1088);
                }
            }
            SEAM(pb + 3);
            if (IN(pb + 4)) { const Params P = load_params(); unsigned char* ws = P.ws;
                for (int it = blockIdx.x; it < 64; it += G) attn_combine(lds, P, l, it >> 2, it & 3);
                pg8::Gemm g{(const pg8::bf16_t*)(ws + WS_MIX), (const pg8::bf16_t*)(ws + WS_WOUT) + (size_t)l * SZ_WOUT, MP, DM, DM};
                pg8::FoldOrder S; S.init(MP, DM, G, (int)blockIdx.x); S.sp = SPTR(P, l * 3, 0); S.cg = LNG(P, l * 3); S.bw = LNB(P, l * 3); S.tabs = FOLDP; S.ncall = 0;
                pg8::EpiRes E{nullptr, nullptr, ALPHA, 1.0f, 1, (pg8::ldsf_t)FOLDP, &S,
                              SPTR(P, l * 3 + 1, 0), LNG(P, l * 3 + 1), (pg8::bf16_t*)(ws + WS_XB), TABP, 0};
                pg8::gemm_phase<pg8::EpiRes, pg8::FoldOrder, true, true>(lds, g, S, E);
            }
            SEAM(pb + 4);
        }
    }
    if (IN(NPHASE - 1)) {
        const Params P = load_params(); constexpr int lj = (NLAYER - 1) * 3 + 2;
        final_ln(P, G, (const float*)(P.ws + WS_STATS) + (size_t)(lj & 1) * MT * 8, P.in[6] + (size_t)lj * DM, P.in[7] + (size_t)lj * DM, P.out + O_Y);
    }
#undef SPTR
#undef LNG
#undef LNB
#undef CGP
#undef TABP
#undef FOLDP
#undef IN
#undef SUBBAR
#undef LNP
#undef SEAM
}

#ifndef MK_N_LAUNCHES
#define MK_N_LAUNCHES 1
#endif
extern "C" void kernel_launch(void* const* d_in, const int* in_sizes, int n_in, void* d_out, int out_size, void* d_ws, size_t ws_size, hipStream_t stream) {
    static int grid = 0;
    if (grid == 0) {
        if (n_in != 18 || (size_t)out_size != O_END || ws_size < WS_END) { fprintf(stderr, "kernel_launch: unexpected shapes: n_in %d out_size %d ws_size %zu\n", n_in, out_size, ws_size); grid = -1; return; }
        int dev = 0, cus = 0, per_cu = 0;
        if (hipGetDevice(&dev) != hipSuccess || hipDeviceGetAttribute(&cus, hipDeviceAttributeMultiprocessorCount, dev) != hipSuccess) { grid = -1; return; }
        if (hipFuncSetAttribute((const void*)fwd_megakernel, hipFuncAttributeMaxDynamicSharedMemorySize, LDS_BYTES) != hipSuccess) { fprintf(stderr, "kernel_launch: hipFuncSetAttribute failed\n"); grid = -1; return; }
        if (hipOccupancyMaxActiveBlocksPerMultiprocessor(&per_cu, (const void*)fwd_megakernel, NTHR, LDS_BYTES) != hipSuccess || per_cu < 1) { fprintf(stderr, "kernel_launch: occupancy query gave %d\n", per_cu); per_cu = 1; }
        (void)hipGetLastError();
        grid = cus * per_cu;
        fprintf(stderr, "kernel_launch: grid %d (cus %d x %d)\n", grid, cus, per_cu);
    }
    if (grid < 0) return;
    Params p{};
    for (int i = 0; i < 18; ++i) p.in[i] = (const float*)d_in[i];
    p.out = (float*)d_out; p.ws = (unsigned char*)d_ws;
    const int nl = MK_N_LAUNCHES;
    for (int li = 0; li < nl; ++li) {
        p.ph_lo = (int)((long)NPHASE * li / nl); p.ph_hi = (int)((long)NPHASE * (li + 1) / nl);
        void* args[] = {&p};
        hipError_t e = hipLaunchCooperativeKernel((const void*)fwd_megakernel, dim3(grid), dim3(NTHR), args, LDS_BYTES, stream);
        if (e != hipSuccess) { fprintf(stderr, "kernel_launch: cooperative launch %d failed: %s (grid %d)\n", li, hipGetErrorString(e), grid); break; }
    }
}
```
